# Optimizing an MI355X kernel written in HIP

```python
import jax, jax.numpy as jnp
from jax import lax
import numpy as np

D_MODEL = 4096
BATCH = 2
SEQ = 4096
DEPTH = 2

GRID_W = 64
CTX_LEN = 256
MIX_W = D_MODEL
M_WIDTH = MIX_W // 2
M_HEADS = 4
M_DV = M_WIDTH // M_HEADS
M_DK = M_DV // 2
CHUNK = 128
A_WIDTH = MIX_W - M_WIDTH
HEAD_DIM = 128
A_HEADS = A_WIDTH // HEAD_DIM
KV_HEADS = A_HEADS // 4
Q_BLOCK = 128
ROPE_AXIS_DIM = HEAD_DIM // 2
ROPE_THETA = 10000.0
EPS = 1e-6
FORGET_BIAS = 3.0
SPLITS = (M_HEADS * M_DK, M_HEADS * M_DK, M_WIDTH, M_WIDTH, M_WIDTH, 4 * M_HEADS,
          A_WIDTH, KV_HEADS * HEAD_DIM, KV_HEADS * HEAD_DIM, A_WIDTH)
IN_COLS = sum(SPLITS)

kernel_name = "hymba_mlstm_gqa_prefix_dit"


def rmsnorm(x, g):
    x32 = x.astype(jnp.float32)
    y = x32 * lax.rsqrt(jnp.mean(x32 * x32, axis=-1, keepdims=True) + EPS)
    return (y * g.astype(jnp.float32)).astype(x.dtype)


def split_cols(p):
    idx, acc = [], 0
    for s in SPLITS[:-1]:
        acc += s
        idx.append(acc)
    return jnp.split(p, idx, axis=-1)


def rope_tables(T):
    rows = T // GRID_W
    row_ids = jnp.repeat(jnp.arange(rows), GRID_W).astype(jnp.float32)
    col_ids = jnp.tile(jnp.arange(GRID_W), rows).astype(jnp.float32)
    inv = ROPE_THETA ** (-jnp.arange(0, ROPE_AXIS_DIM, 2, dtype=jnp.float32) / ROPE_AXIS_DIM)
    ang = jnp.concatenate([row_ids[:, None] * inv, col_ids[:, None] * inv], axis=-1)
    return jnp.cos(ang), jnp.sin(ang)


def apply_rope_2d(x, cos, sin):
    xf = x.astype(jnp.float32)
    nf = ROPE_AXIS_DIM // 2

    def rot(xp, cs, sn):
        x1, x2 = xp[..., :nf], xp[..., nf:]
        cs, sn = cs[None, :, None, :], sn[None, :, None, :]
        return jnp.concatenate([x1 * cs - x2 * sn, x1 * sn + x2 * cs], axis=-1)

    out = jnp.concatenate([
        rot(xf[..., :ROPE_AXIS_DIM], cos[:, :nf], sin[:, :nf]),
        rot(xf[..., ROPE_AXIS_DIM:], cos[:, nf:], sin[:, nf:])], axis=-1)
    return out.astype(x.dtype)


def mlstm_chunked(q, k, v, log_i, log_f, state):
    B, H, T, _ = q.shape
    DV = v.shape[-1]
    nc = T // CHUNK

    def chunks(a):
        return jnp.moveaxis(a.reshape((B, H, nc, CHUNK) + a.shape[3:]), 2, 0)

    tril = jnp.tril(jnp.ones((CHUNK, CHUNK), dtype=bool))

    def step(carry, inp):
        C, n, m = carry
        qc, kc, vc, ic, fc = inp
        b = jnp.cumsum(fc, axis=-1)
        logw = b[..., :, None] - b[..., None, :] + ic[..., None, :]
        logw = jnp.where(tril, logw, -jnp.inf)
        m_state = b + m[..., None]
        m_t = jnp.maximum(m_state, jnp.max(logw, axis=-1))
        w_state = jnp.exp(m_state - m_t)
        s = jnp.einsum('bhtd,bhsd->bhts', qc, kc) * jnp.exp(logw - m_t[..., None])
        num = (w_state[..., None] * jnp.einsum('bhvd,bhtd->bhtv', C, qc)
               + jnp.einsum('bhts,bhsv->bhtv', s, vc))
        den = w_state * jnp.einsum('bhd,bhtd->bht', n, qc) + jnp.sum(s, axis=-1)
        h = num / jnp.maximum(jnp.abs(den), jnp.exp(-m_t))[..., None]
        m_new = m_t[..., -1]
        w_s = jnp.exp(b[..., -1:] - b + ic - m_new[..., None])
        a_state = jnp.exp(b[..., -1] + m - m_new)
        C_new = a_state[..., None, None] * C + jnp.einsum('bhs,bhsv,bhsd->bhvd', w_s, vc, kc)
        n_new = a_state[..., None] * n + jnp.einsum('bhs,bhsd->bhd', w_s, kc)
        return (C_new, n_new, m_new), h

    state, hs = lax.scan(step, state, tuple(chunks(a) for a in (q, k, v, log_i, log_f)))
    return jnp.moveaxis(hs, 0, 2).reshape(B, H, T, DV), state


def mlstm_branch(parts_ctx, parts_lat, b_gate, g_mlstm):
    def prep(parts):
        q, k, v, o, z, g = parts
        B, T, _ = q.shape

        def heads(a, d):
            return a.reshape(B, T, M_HEADS, d).transpose(0, 2, 1, 3).astype(jnp.float32)

        gates = (g.astype(jnp.float32) + b_gate.astype(jnp.float32)).reshape(B, T, 4, M_HEADS)
        gates = gates.transpose(2, 0, 3, 1)
        return dict(q=heads(q, M_DK) * (M_DK ** -0.5), k=heads(k, M_DK), v=heads(v, M_DV),
                    o=o.astype(jnp.float32), z=z.astype(jnp.float32),
                    i_f=gates[0], f_f=jax.nn.log_sigmoid(gates[1]),
                    i_b=gates[2], f_b=jax.nn.log_sigmoid(gates[3]))

    pc, pl = prep(parts_ctx), prep(parts_lat)
    B = pl['q'].shape[0]
    zero = (jnp.zeros((B, M_HEADS, M_DV, M_DK), jnp.float32),
            jnp.zeros((B, M_HEADS, M_DK), jnp.float32),
            jnp.zeros((B, M_HEADS), jnp.float32))
    flip = lambda a: jnp.flip(a, axis=2)

    h_cf, st_cf = mlstm_chunked(pc['q'], pc['k'], pc['v'], pc['i_f'], pc['f_f'], zero)
    h_lf, _ = mlstm_chunked(pl['q'], pl['k'], pl['v'], pl['i_f'], pl['f_f'], st_cf)
    h_cb, st_cb = mlstm_chunked(flip(pc['q']), flip(pc['k']), flip(pc['v']),
                                flip(pc['i_b']), flip(pc['f_b']), zero)
    h_lb, _ = mlstm_chunked(flip(pl['q']), flip(pl['k']), flip(pl['v']),
                            flip(pl['i_b']), flip(pl['f_b']), st_cb)
    gm = g_mlstm.astype(jnp.float32).reshape(M_HEADS, 1, M_DV)

    def finish(h, p, dtype):
        hn = h * lax.rsqrt(jnp.mean(h * h, axis=-1, keepdims=True) + EPS) * gm
        B_, _, T_, _ = hn.shape
        hn = hn.transpose(0, 2, 1, 3).reshape(B_, T_, M_WIDTH)
        return (hn * jax.nn.sigmoid(p['o']) * jax.nn.silu(p['z'])).astype(dtype)

    out_lat = finish(h_lf + flip(h_lb), pl, parts_lat[0].dtype)
    out_ctx = finish(h_cf + flip(h_cb), pc, parts_ctx[0].dtype)
    return out_lat, out_ctx


def gqa_block(qb, k_all, v_all):
    s = jnp.einsum('bqhgd,bkhd->bhgqk', qb, k_all).astype(jnp.float32) * (HEAD_DIM ** -0.5)
    p = jax.nn.softmax(s, axis=-1)
    return jnp.einsum('bhgqk,bkhd->bqhgd', p.astype(v_all.dtype), v_all)


def attn_branch(parts_ctx, parts_lat, g_q, g_k, rope_cos, rope_sin, update_ctx):
    G = A_HEADS // KV_HEADS

    def prep(parts):
        q, k, v, z = parts
        B, T, _ = q.shape
        q = rmsnorm(q.reshape(B, T, A_HEADS, HEAD_DIM), g_q)
        k = rmsnorm(k.reshape(B, T, KV_HEADS, HEAD_DIM), g_k)
        return q, k, v.reshape(B, T, KV_HEADS, HEAD_DIM), z

    qc, kc, vc, zc = prep(parts_ctx)
    ql, kl, vl, zl = prep(parts_lat)
    ql = apply_rope_2d(ql, rope_cos, rope_sin)
    kl = apply_rope_2d(kl, rope_cos, rope_sin)
    k_all = jnp.concatenate([kc, kl], axis=1)
    v_all = jnp.concatenate([vc, vl], axis=1)
    B, T = ql.shape[0], ql.shape[1]
    nb = T // Q_BLOCK
    qs = ql.reshape(B, nb, Q_BLOCK, KV_HEADS, G, HEAD_DIM).transpose(1, 0, 2, 3, 4, 5)
    outs = lax.map(lambda qb: gqa_block(qb, k_all, v_all), qs)
    o_lat = outs.transpose(1, 0, 2, 3, 4, 5).reshape(B, T, A_WIDTH)
    out_lat = o_lat * jax.nn.silu(zl)
    out_ctx = None
    if update_ctx:
        Tc = qc.shape[1]
        o_ctx = gqa_block(qc.reshape(B, Tc, KV_HEADS, G, HEAD_DIM), kc, vc).reshape(B, Tc, A_WIDTH)
        out_ctx = o_ctx * jax.nn.silu(zc)
    return out_lat, out_ctx


def hybrid_layer(x, ctx, c, c_ctx, w_mod, b_mod, g_norm, w_in, b_gate, g_mlstm, g_q, g_k,
                 w_out, rope_cos, rope_sin, update_ctx):
    shift, scale, gate = jnp.split(jax.nn.silu(c) @ w_mod + b_mod, 3, axis=-1)
    shift_c, scale_c, gate_c = jnp.split(jax.nn.silu(c_ctx) @ w_mod + b_mod, 3, axis=-1)
    h = rmsnorm(x, g_norm) * (1 + scale[:, None, :]) + shift[:, None, :]
    hc = rmsnorm(ctx, g_norm) * (1 + scale_c) + shift_c
    parts = split_cols(h @ w_in)
    parts_c = split_cols(hc @ w_in)
    m_lat, m_ctx = mlstm_branch(parts_c[:6], parts[:6], b_gate, g_mlstm)
    a_lat, a_ctx = attn_branch(parts_c[6:], parts[6:], g_q, g_k, rope_cos, rope_sin, update_ctx)
    x = x + gate[:, None, :] * (jnp.concatenate([m_lat, a_lat], axis=-1) @ w_out)
    if update_ctx:
        ctx = ctx + gate_c * (jnp.concatenate([m_ctx, a_ctx], axis=-1) @ w_out)
    return x, ctx


def setup_inputs(seed: int = 0) -> dict:
    key = jax.random.key(seed)
    ks = jax.random.split(key, 16)
    nrm = jax.random.normal
    f32 = jnp.float32
    b_gate = (0.1 * nrm(ks[8], (DEPTH, 4, M_HEADS), f32)
              + jnp.array([0.0, FORGET_BIAS, 0.0, FORGET_BIAS], f32)[None, :, None])
    return {
        "x": nrm(ks[0], (BATCH, SEQ, D_MODEL), f32),
        "c": nrm(ks[1], (BATCH, D_MODEL), f32),
        "ctx": nrm(ks[2], (BATCH, CTX_LEN, D_MODEL), f32),
        "c_ctx": nrm(ks[3], (D_MODEL,), f32),
        "w_mod": nrm(ks[4], (DEPTH, D_MODEL, 3 * D_MODEL), f32) * (0.5 * D_MODEL ** -0.5),
        "b_mod": 0.01 * nrm(ks[5], (DEPTH, 3 * D_MODEL), f32),
        "g_norm": 1.0 + 0.05 * nrm(ks[6], (DEPTH, D_MODEL), f32),
        "w_in": nrm(ks[7], (DEPTH, D_MODEL, IN_COLS), f32) * (D_MODEL ** -0.5),
        "b_gate": b_gate.reshape(DEPTH, 4 * M_HEADS),
        "g_mlstm": 1.0 + 0.05 * nrm(ks[9], (DEPTH, M_WIDTH), f32),
        "g_q": 1.0 + 0.05 * nrm(ks[10], (DEPTH, HEAD_DIM), f32),
        "g_k": 1.0 + 0.05 * nrm(ks[11], (DEPTH, HEAD_DIM), f32),
        "w_out": nrm(ks[12], (DEPTH, MIX_W, D_MODEL), f32) * (MIX_W ** -0.5),
        "g_final": 1.0 + 0.05 * nrm(ks[13], (D_MODEL,), f32),
    }


def reference(x, c, ctx, c_ctx, w_mod, b_mod, g_norm, w_in, b_gate, g_mlstm, g_q, g_k,
              w_out, g_final):
    rope_cos, rope_sin = rope_tables(x.shape[1])
    for layer in range(DEPTH):
        x, ctx = hybrid_layer(x, ctx, c, c_ctx, w_mod[layer], b_mod[layer], g_norm[layer],
                              w_in[layer], b_gate[layer], g_mlstm[layer], g_q[layer], g_k[layer],
                              w_out[layer], rope_cos, rope_sin, layer < DEPTH - 1)
    return rmsnorm(x, g_final)
```

```cpp
#include <hip/hip_runtime.h>
#include <cstdio>
#include <cstdint>
namespace pg8 {
#define PG8_LAS __attribute__((address_space(3)))
typedef unsigned short bf16_t;
typedef short bf16x8 __attribute__((ext_vector_type(8)));
typedef float f32x4 __attribute__((ext_vector_type(4)));
typedef unsigned u32x4 __attribute__((ext_vector_type(4)));
constexpr int BM = 256, BK = 64, HALF = 128, HTB = HALF * BK * 2  , STAGE_BYTES = 8 * HTB, NXCD = 8, WGM = 8;

__host__ __device__ __forceinline__ int lds_byte(int r, int c) { const int st = (r >> 4) * 2 + (c >> 5), rr = r & 15, cc = c & 31, ob = rr * 64 + cc * 2; return st * 1024 + (ob ^ (((ob >> 9) & 1) << 5)); }
__host__ __device__ __forceinline__ void stage_rc(int b, int& R, int& C) { const int st = b / 1024, sb = b % 1024, swz = sb ^ (((sb >> 9) & 1) << 5); R = (st >> 1) * 16 + swz / 64; C = (st & 1) * 32 + (swz % 64) / 2; }
__host__ __device__ __forceinline__ int perm32(int rho) { const int n = rho >> 4, i = rho & 15; return 8 * (i >> 2) + 4 * n + (i & 3); }

struct Unit { int pm, pn; };
struct Gemm { const bf16_t* A; const bf16_t* Bt; int M, N, K, ld; };

struct StaticOrder {
    int nM, nN, nwg, G, c;
    __host__ __device__ void init(int M, int N, int G_, int c_) { nM = M / BM; nN = N / BM; nwg = nM * nN; G = G_; c = c_; }
    __host__ __device__ bool next(int i, Unit& u) const {
        const long L = (long)i * G + c; if (L >= nwg) return false;
        int wgid = (int)L; { const int q = nwg / NXCD, r = nwg % NXCD, xcd = wgid % NXCD, off = wgid / NXCD; wgid = (xcd < r ? xcd * (q + 1) : r * (q + 1) + (xcd - r) * q) + off; }
        const int nig = WGM * nN, gid = wgid / nig, fm = gid * WGM, gsz = (nM - fm) < WGM ? (nM - fm) : WGM;
        u.pm = fm + ((wgid % nig) % gsz); u.pn = (wgid % nig) / gsz; return true;
    }
    __device__ __forceinline__ void a_ready(const Unit&) const {}
    __device__ __forceinline__ void done(const Unit&) const {}
};

__device__ __forceinline__ unsigned cvt_pk_bf16(float lo, float hi) { unsigned r; asm volatile("v_cvt_pk_bf16_f32 %0, %1, %2" : "=v"(r) : "v"(lo), "v"(hi)); return r; }
typedef float f32x2 __attribute__((ext_vector_type(2)));
template <class Epi, class Sched, bool ALIGN_EPI = false, bool SP2 = false>
__device__ __forceinline__ void gemm_phase(PG8_LAS unsigned char* lds, const Gemm g, const Sched& S, const Epi& E, const int tid_in) {
    const int tid = tid_in, wid = __builtin_amdgcn_readfirstlane(tid >> 6), lane = tid & 63, wr = wid >> 2, wc = wid & 3, fr = lane & 15, fq = lane >> 4;
    const int K = g.ld, nt = g.K / BK;
    unsigned voffA[2], voffB[2];
#pragma unroll
    for (int i = 0; i < 2; ++i) { int R, C; stage_rc(tid * 16 + i * 8192, R, C); const int Rb = Epi::PERM ? ((R & ~31) + perm32(R & 31)) : R;
        voffA[i] = (unsigned)(R * K + C) * 2u; voffB[i] = (unsigned)(Rb * K + C) * 2u; }
    const size_t kstep = (size_t)(BK * 2);
    const size_t hstep = (size_t)HALF * K * 2;
    const size_t tstep = 2 * hstep;
    const unsigned ldsw = (unsigned)wid * 1024u;
    const int aoff = lds_byte(wr * 64 + fr, fq * 8), boff = lds_byte(wc * 32 + fr, fq * 8);
#define PG8_SA(b, h) (((b) * 2 + (h)) * HTB)
#define PG8_SB(b, h) ((4 + (b) * 2 + (h)) * HTB)
#define PG8_STAGE(bufoff, gbase, voff) do { _Pragma("unroll") for (int _i = 0; _i < 2; ++_i) \
        __builtin_amdgcn_global_load_lds((const unsigned*)((const char*)(gbase) + (voff)[_i]), (PG8_LAS unsigned*)(lds + (bufoff) + ldsw + _i * 8192), 16, 0, 0); } while (0)
#define PG8_LDA(dst, b, h) do { _Pragma("unroll") for (int m = 0; m < 4; ++m) _Pragma("unroll") for (int k = 0; k < 2; ++k) dst[m][k] = *(const PG8_LAS bf16x8*)(lds + PG8_SA(b, h) + aoff + m * 2048 + k * 1024); } while (0)
#define PG8_LDB(dst, b, h) do { _Pragma("unroll") for (int n = 0; n < 2; ++n) _Pragma("unroll") for (int k = 0; k < 2; ++k) dst[n][k] = *(const PG8_LAS bf16x8*)(lds + PG8_SB(b, h) + boff + n * 2048 + k * 1024); } while (0)
#define PG8_MMA(ai, bj, At, Bt) do { __builtin_amdgcn_s_setprio(1); _Pragma("unroll") for (int m = 0; m < 4; ++m) _Pragma("unroll") for (int n = 0; n < 2; ++n) _Pragma("unroll") for (int k = 0; k < 2; ++k) \
        acc[ai][bj][m][n] = __builtin_amdgcn_mfma_f32_16x16x32_bf16(Bt[n][k], At[m][k], acc[ai][bj][m][n], 0, 0, 0); __builtin_amdgcn_s_setprio(0); } while (0)
#define PG8_WAIT_V(n) asm volatile("s_waitcnt vmcnt(" #n ")" ::: "memory")
#define PG8_WAIT_L(n) asm volatile("s_waitcnt lgkmcnt(" #n ")" ::: "memory")
#define PG8_BAR __builtin_amdgcn_s_barrier()
#define PG8_SCHED __builtin_amdgcn_sched_barrier(0)
    Unit cur, nxt; int ui = 0;
    if (!S.next(0, cur)) return;
    f32x4 acc[2][2][4][2];
#pragma unroll
    for (int a = 0; a < 2; ++a)
#pragma unroll
        for (int b = 0; b < 2; ++b)
#pragma unroll
            for (int m = 0; m < 4; ++m)
#pragma unroll
                for (int n = 0; n < 2; ++n) acc[a][b][m][n] = (f32x4){0.f, 0.f, 0.f, 0.f};
    bf16x8 At[4][2], B0[2][2], B1[2][2];
    const char* cA = (const char*)g.A + (size_t)cur.pm * tstep; const char* cB = (const char*)g.Bt + (size_t)cur.pn * tstep;
    S.a_ready(cur);
    if constexpr (SP2) {
        PG8_STAGE(PG8_SB(0, 0), cB, voffB); PG8_STAGE(PG8_SB(0, 1), cB + hstep, voffB); PG8_STAGE(PG8_SA(0, 0), cA, voffA); PG8_STAGE(PG8_SA(0, 1), cA + hstep, voffA);
        if (wr == 1) PG8_BAR;
        PG8_WAIT_V(2); PG8_BAR;
        PG8_STAGE(PG8_SB(1, 0), cB + kstep, voffB); PG8_STAGE(PG8_SA(1, 0), cA + kstep, voffA); PG8_STAGE(PG8_SB(1, 1), cB + hstep + kstep, voffB);
        PG8_WAIT_V(6); PG8_BAR;
    } else {
        PG8_STAGE(PG8_SB(0, 0), cB, voffB); PG8_STAGE(PG8_SA(0, 0), cA, voffA); PG8_STAGE(PG8_SB(0, 1), cB + hstep, voffB); PG8_STAGE(PG8_SA(0, 1), cA + hstep, voffA);
        if (wr == 1) PG8_BAR;
        PG8_WAIT_V(4); PG8_BAR;
        PG8_STAGE(PG8_SB(1, 0), cB + kstep, voffB); PG8_STAGE(PG8_SA(1, 0), cA + kstep, voffA); PG8_STAGE(PG8_SB(1, 1), cB + hstep + kstep, voffB);
        PG8_WAIT_V(6); PG8_BAR;
    }
    for (;;) {
        const bool has_next = S.next(ui + 1, nxt);
        const char* nA = has_next ? (const char*)g.A + (size_t)nxt.pm * tstep : cA; const char* nB = has_next ? (const char*)g.Bt + (size_t)nxt.pn * tstep : cB;
        for (int t = 0; t < nt; t += 2) {
            const bool last = (t == nt - 2);
            const char* a1 = cA + (size_t)(t + 1) * kstep;
            const char* a2 = last ? nA : cA + (size_t)(t + 2) * kstep; const char* b2 = last ? nB : cB + (size_t)(t + 2) * kstep;
            const char* a3 = a2 + kstep; const char* b3 = b2 + kstep;
            if (last && has_next) S.a_ready(nxt);
            if constexpr (SP2) {
            PG8_LDB(B0, 0, 0); PG8_LDB(B1, 0, 1); PG8_SCHED; PG8_LDA(At, 0, 0); PG8_STAGE(PG8_SA(1, 1), a1 + hstep, voffA);
            PG8_WAIT_V(8); PG8_WAIT_L(0); PG8_BAR; PG8_MMA(0, 0, At, B0); PG8_MMA(0, 1, At, B1); PG8_BAR; PG8_SCHED;
            PG8_LDA(At, 0, 1); PG8_STAGE(PG8_SB(0, 0), b2, voffB); PG8_STAGE(PG8_SB(0, 1), b2 + hstep, voffB); PG8_STAGE(PG8_SA(0, 0), a2, voffA);
            PG8_WAIT_V(8); PG8_WAIT_L(0); PG8_BAR; PG8_MMA(1, 0, At, B0); PG8_MMA(1, 1, At, B1); PG8_BAR; PG8_SCHED;
            PG8_LDB(B0, 1, 0); PG8_LDB(B1, 1, 1); PG8_SCHED; PG8_LDA(At, 1, 0); PG8_STAGE(PG8_SA(0, 1), a2 + hstep, voffA);
            PG8_WAIT_V(8); PG8_WAIT_L(0); PG8_BAR; PG8_MMA(0, 0, At, B0); PG8_MMA(0, 1, At, B1); PG8_BAR; PG8_SCHED;
            PG8_LDA(At, 1, 1); PG8_STAGE(PG8_SB(1, 0), b3, voffB); PG8_STAGE(PG8_SB(1, 1), b3 + hstep, voffB); PG8_STAGE(PG8_SA(1, 0), a3, voffA);
            PG8_WAIT_V(8); PG8_WAIT_L(0); PG8_BAR; PG8_MMA(1, 0, At, B0); PG8_MMA(1, 1, At, B1); PG8_BAR; PG8_SCHED;
            } else {
            PG8_LDB(B0, 0, 0); PG8_SCHED; PG8_LDA(At, 0, 0); PG8_STAGE(PG8_SA(1, 1), a1 + hstep, voffA);
            PG8_WAIT_L(8); PG8_BAR; PG8_WAIT_L(0); PG8_MMA(0, 0, At, B0); PG8_BAR; PG8_SCHED;
            PG8_LDB(B1, 0, 1); PG8_STAGE(PG8_SB(0, 0), b2, voffB);
            PG8_BAR; PG8_WAIT_L(0); PG8_MMA(0, 1, At, B1); PG8_BAR;
            PG8_LDA(At, 0, 1); PG8_STAGE(PG8_SA(0, 0), a2, voffA);
            PG8_BAR; PG8_WAIT_L(0); PG8_MMA(1, 0, At, B0); PG8_BAR; PG8_SCHED;
            PG8_STAGE(PG8_SB(0, 1), b2 + hstep, voffB);
            PG8_WAIT_V(6); PG8_BAR; PG8_MMA(1, 1, At, B1); PG8_BAR;
            PG8_LDB(B0, 1, 0); PG8_SCHED; PG8_LDA(At, 1, 0); PG8_STAGE(PG8_SA(0, 1), a2 + hstep, voffA);
            PG8_WAIT_L(8); PG8_BAR; PG8_WAIT_L(0); PG8_MMA(0, 0, At, B0); PG8_BAR; PG8_SCHED;
            PG8_LDB(B1, 1, 1); PG8_STAGE(PG8_SB(1, 0), b3, voffB);
            PG8_BAR; PG8_WAIT_L(0); PG8_MMA(0, 1, At, B1); PG8_BAR;
            PG8_LDA(At, 1, 1); PG8_STAGE(PG8_SA(1, 0), a3, voffA);
            PG8_BAR; PG8_WAIT_L(0); PG8_MMA(1, 0, At, B0); PG8_BAR; PG8_SCHED;
            PG8_STAGE(PG8_SB(1, 1), b3 + hstep, voffB);
            PG8_WAIT_V(6); PG8_BAR; PG8_MMA(1, 1, At, B1); PG8_BAR;
            }
        }
        if constexpr (ALIGN_EPI) { if (wr == 0) PG8_BAR; }
        if constexpr (!Epi::AFTER_DRAIN) { E(acc, cur, wr, wc, fr, fq); S.done(cur); }
        if (!has_next) break;
#pragma unroll
        for (int a = 0; a < 2; ++a)
#pragma unroll
            for (int b = 0; b < 2; ++b)
#pragma unroll
                for (int m = 0; m < 4; ++m)
#pragma unroll
                    for (int n = 0; n < 2; ++n) acc[a][b][m][n] = (f32x4){0.f, 0.f, 0.f, 0.f};
        cur = nxt; cA = nA; cB = nB; ++ui;
        if constexpr (ALIGN_EPI) { if (wr == 1) PG8_BAR; }
    }
    PG8_WAIT_V(0);
    if constexpr (!ALIGN_EPI) { if (wr == 0) PG8_BAR; }
    PG8_BAR;
    if constexpr (Epi::AFTER_DRAIN) { E.fused(acc, cur, wr, wc, fr, fq, lds, wid, lane); S.done(cur); }
#undef PG8_SA
#undef PG8_SB
#undef PG8_STAGE
#undef PG8_LDA
#undef PG8_LDB
#undef PG8_MMA
#undef PG8_WAIT_V
#undef PG8_WAIT_L
#undef PG8_BAR
#undef PG8_SCHED
}
}

#ifndef PG8_SP2
#define PG8_SP2 true
#endif
#ifndef PG8_ALIGN
#define PG8_ALIGN true
#endif
#ifndef MK_MASK
#define MK_MASK 0x7ff
#endif
#define PH_ON(k) (((MK_MASK) >> (k)) & 1)
#ifndef MK_REP
#define MK_REP 0
#endif
#define REP_ON(k) (((MK_REP) >> (k)) & 1)
#ifndef MK_NREP
#define MK_NREP 1
#endif
#ifndef MK_SUB
#define MK_SUB 0
#endif
#ifndef MK_NSPLIT
#define MK_NSPLIT 64
#endif
#ifndef MK_NOBAR1
#define MK_NOBAR1 1
#endif
#ifndef MK_NOBAR0
#define MK_NOBAR0 1
#endif
#ifndef MK_DEFERWIN1
#define MK_DEFERWIN1 1
#endif
#ifndef MK_DEFERWOUT
#define MK_DEFERWOUT 1
#endif
#ifndef MK_GATESLIGHT
#define MK_GATESLIGHT 1
#endif
#ifndef MK_FUSEL0
#define MK_FUSEL0 1
#endif
#ifndef MK_FUSEFIN
#define MK_FUSEFIN 1
#endif
#ifndef MK_FIXM
#define MK_FIXM 1
#endif
#ifndef MK_EPILDS
#define MK_EPILDS 1
#endif
#ifndef MK_XR16
#define MK_XR16 1
#endif
#ifndef MK_CTXSKIP
#define MK_CTXSKIP 1
#endif
#ifndef MK_QORDER
#define MK_QORDER 1
#endif
#ifndef MK_M2RING
#define MK_M2RING 4
#endif
#ifndef MK_PER_PHASE
#define MK_PER_PHASE 0
#endif

#define GAS __attribute__((address_space(1)))
#define LAS __attribute__((address_space(3)))
typedef unsigned short bf16;
typedef short bf16x8 __attribute__((ext_vector_type(8)));
typedef short s16x4 __attribute__((ext_vector_type(4)));
typedef float f32x2 __attribute__((ext_vector_type(2)));
typedef float f32x4 __attribute__((ext_vector_type(4)));
typedef float f32x8 __attribute__((ext_vector_type(8)));
typedef float f32x16 __attribute__((ext_vector_type(16)));
typedef unsigned u32x2 __attribute__((ext_vector_type(2)));
typedef unsigned u32x4 __attribute__((ext_vector_type(4)));

constexpr int DM = 4096, NBATCH = 2, SEQ = 4096, CTXL = 256, TT = SEQ + CTXL, MROWS = NBATCH * TT;
constexpr int IN_COLS = 13328, NIN = 13312, MODW = 3 * DM;
constexpr int MH = 4, MDK = 256, MDV = 512, CHK = 128, NCH = TT / CHK, MQW = MH * MDK, MVW = MH * MDV;
constexpr int AHQ = 16, AKVH = 4, HD = 128, AQW = AHQ * HD, AKW = AKVH * HD;
constexpr float EPS = 1e-6f;
constexpr int NSEQ = 16;
constexpr int NPANEL = MROWS / 16;
static_assert(TT == 4352 && MROWS == 8704 && NCH == 34 && TT % 256 == 0, "shapes");
constexpr int SC_MQ = 0, SC_MK = 1024, SC_MV = 2048, SC_MO = 4096, SC_MZ = 6144, SC_G = 8192, SC_AQ = 8208, SC_AK = 10256, SC_AV = 10768, SC_AZ = 11280;
constexpr int DN_MQ = 0, DN_MK = 1024, DN_MV = 2048, DN_OZ = 4096, DN_AQ = 8192, DN_AK = 10240, DN_AV = 10752, DN_AZ = 11264;

constexpr size_t al256(size_t x) { return (x + 255) & ~(size_t)255; }
constexpr size_t WS_CTL = 0, CTL_BYTES = 1u << 20;
constexpr int CW_BAR = 4096, CW_QUEUE = 8192;
constexpr size_t CTL_MOD_OFF = 512 * 1024;
static_assert(CTL_MOD_OFF + 2 * 3 * MODW * 4 <= CTL_BYTES, "ctl");
constexpr size_t WS_WINT  = CTL_BYTES;
constexpr size_t WS_WGT   = al256(WS_WINT + (size_t)2 * NIN * DM * 2);
constexpr size_t WS_WOUTT = al256(WS_WGT + (size_t)2 * 16 * DM * 2);
constexpr size_t WS_ROPE  = al256(WS_WOUTT + (size_t)2 * DM * DM * 2);
constexpr size_t WS_XN    = al256(WS_ROPE + 2 * 64 * 32 * 4);
constexpr size_t WS_MQ    = al256(WS_XN + (size_t)MROWS * DM * 2);
constexpr size_t WS_MK    = al256(WS_MQ + (size_t)MROWS * MQW * 2);
constexpr size_t WS_MV    = al256(WS_MK + (size_t)MROWS * MQW * 2);
constexpr size_t WS_MG    = al256(WS_MV + (size_t)MROWS * MVW * 2);
constexpr size_t WS_AQ    = al256(WS_MG + (size_t)MROWS * MVW * 2);
constexpr size_t WS_AK    = al256(WS_AQ + (size_t)MROWS * AQW * 2);
constexpr size_t WS_AV    = al256(WS_AK + (size_t)MROWS * AKW * 2);
constexpr size_t WS_ASZ   = al256(WS_AV + (size_t)MROWS * AKW * 2);
constexpr size_t WS_GATES = al256(WS_ASZ + (size_t)MROWS * AQW * 2);
constexpr size_t WS_VT    = al256(WS_GATES + (size_t)MROWS * 16 * 4);
constexpr size_t WS_KT    = al256(WS_VT + (size_t)NBATCH * MH * MDV * TT * 2);
constexpr size_t WS_SCAN  = al256(WS_KT + (size_t)NBATCH * MH * MDK * TT * 2);
constexpr size_t SCAN_ARR = (size_t)NSEQ * TT * 4;
constexpr size_t WS_ACH   = al256(WS_SCAN + 5 * SCAN_ARR);
constexpr size_t WS_CST   = al256(WS_ACH + (size_t)4 * NSEQ * NCH * 4);
constexpr size_t WS_NST   = al256(WS_CST + (size_t)NSEQ * NCH * MDV * MDK * 2);
constexpr size_t WS_Y     = al256(WS_NST + (size_t)NSEQ * NCH * MDK * 4);
constexpr size_t WS_XR1   = al256(WS_Y + (size_t)MROWS * DM * 2);
constexpr size_t WS_AQN   = al256(WS_XR1 + (size_t)MROWS * DM * 4);
constexpr size_t WS_AKN   = al256(WS_AQN + (size_t)MROWS * AQW * 2);
constexpr size_t WS_PART  = al256(WS_AKN + (size_t)MROWS * AKW * 2);
constexpr int NSPLIT = MK_NSPLIT, NPART = 4;
constexpr size_t WS_APART = al256(WS_PART + (size_t)8 * NBATCH * CTXL * DM * 4);
constexpr size_t WS_FSLOT = al256(WS_APART + (size_t)(NSPLIT > 0 ? NSPLIT : 1) * NPART * 66 * 512 * 4);
constexpr size_t WS_END   = al256(WS_FSLOT + (size_t)34 * 16 * 256 * 4);
constexpr int CW_FCNT = 8192 + 64 * 28;

constexpr int LDS_BYTES = 147456;
constexpr int MISC_OFF = 143360;
constexpr int NWAVES = 8;

__device__ __forceinline__ float bflo(unsigned w) { return __uint_as_float(w << 16); }
__device__ __forceinline__ float bfhi(unsigned w) { return __uint_as_float(w & 0xffff0000u); }
__device__ __forceinline__ float bf2f(bf16 h) { return __uint_as_float((unsigned)h << 16); }
__device__ __forceinline__ unsigned cvtpk(float lo, float hi) { unsigned r; asm("v_cvt_pk_bf16_f32 %0, %1, %2" : "=v"(r) : "v"(lo), "v"(hi)); return r; }
__device__ __forceinline__ bf16 f2bf(float f) { return (bf16)(cvtpk(f, 0.f) & 0xffffu); }
__device__ __forceinline__ float shl_idx(float v, int src_lane) { return __int_as_float(__builtin_amdgcn_ds_bpermute(src_lane << 2, __float_as_int(v))); }
__device__ __forceinline__ float shl_xor(float v, int m, int lane) { return shl_idx(v, lane ^ m); }
__device__ __forceinline__ float shl_up(float v, int o, int lane) { return shl_idx(v, lane >= o ? lane - o : lane); }
__device__ __forceinline__ float wave_sum(float v, int lane) {
#pragma unroll
    for (int o = 1; o < 64; o <<= 1) v += shl_xor(v, o, lane);
    return v;
}
__device__ __forceinline__ float sigmoidf_fast(float x) { return __builtin_amdgcn_rcpf(1.0f + __builtin_amdgcn_exp2f(-1.4426950408889634f * x)); }
__device__ __forceinline__ f32x4 mfma16(bf16x8 a, bf16x8 b, f32x4 c) { return __builtin_amdgcn_mfma_f32_16x16x32_bf16(a, b, c, 0, 0, 0); }
template <class T> __device__ __forceinline__ T ldg(const void* p) { return *(const GAS T*)p; }
template <class T> __device__ __forceinline__ void stg(void* p, const T v) { *(GAS T*)p = v; }
__device__ __forceinline__ void stg_wt8(void* p, const u32x2 v) { __hip_atomic_store((GAS unsigned long long*)p, ((unsigned long long)v.y << 32) | v.x, __ATOMIC_RELAXED, __HIP_MEMORY_SCOPE_AGENT); }
__device__ __forceinline__ void stg_wt4(void* p, const unsigned v) { __hip_atomic_store((GAS unsigned*)p, v, __ATOMIC_RELAXED, __HIP_MEMORY_SCOPE_AGENT); }
#define LDS_WAIT() asm volatile("s_waitcnt lgkmcnt(0)" ::: "memory")
#define VM_WAIT() asm volatile("s_waitcnt vmcnt(0)" ::: "memory")

#define XB_TMO      128
#define XB_XCNT(j)  (256  + 64 * (j))
#define XB_XSUB(j)  (1280 + 64 * (j))
#define XB_XGEN(j)  (2304 + 64 * (j))
#define XB_TOP      3328
#define XB_TOPGEN   3392
#define XCD_BAR_WORDS 3456
#define XB_SPIN_CAP (1u << 22)

__device__ __forceinline__ unsigned xb_ld(unsigned* p)              { return __hip_atomic_load(p, __ATOMIC_RELAXED, __HIP_MEMORY_SCOPE_AGENT); }
__device__ __forceinline__ unsigned xb_add(unsigned* p, unsigned v) { return __hip_atomic_fetch_add(p, v, __ATOMIC_RELAXED, __HIP_MEMORY_SCOPE_AGENT); }
__device__ __forceinline__ unsigned xb_xcc_id() { return (unsigned)__builtin_amdgcn_s_getreg((3 << 11) | 20) & 0xFu; }
#define XB_SPIN(cond, bar) do { unsigned _sp = 0; while (cond) { __builtin_amdgcn_s_sleep(1); \
    if ((++_sp & 255u) == 0u) { if (xb_ld(&(bar)[XB_TMO])) break; if (_sp > XB_SPIN_CAP) { atomicAdd(&(bar)[XB_TMO], 1u); break; } } } } while (0)

struct XcdBarrier { unsigned* bar; unsigned x; volatile LAS unsigned* st; };

__device__ __forceinline__ XcdBarrier xcd_barrier_post(unsigned* bar, volatile LAS unsigned* st) {
    XcdBarrier b; b.bar = bar; b.x = xb_xcc_id(); b.st = st;
    if (threadIdx.x == 0) (void)xb_add(&bar[XB_XCNT(b.x)], 1u);
    return b;
}
__device__ __forceinline__ void xcd_barrier_complete(unsigned* bar, unsigned x, unsigned& nloc, unsigned& nx) {
    const unsigned G = gridDim.x * gridDim.y * gridDim.z;
    unsigned sum, cnt, mine, sp = 0u;
    for (;;) {
        sum = 0u; cnt = 0u; mine = 0u;
#pragma unroll
        for (unsigned j = 0; j < 16; ++j) { const unsigned c = xb_ld(&bar[XB_XCNT(j)]); sum += c; cnt += (c > 0u) ? 1u : 0u; mine = (j == x) ? c : mine; }
        if (sum == G) break;
        __builtin_amdgcn_s_sleep(1);
        if ((++sp & 255u) == 0u) { if (xb_ld(&bar[XB_TMO])) break; if (sp > XB_SPIN_CAP) { atomicAdd(&bar[XB_TMO], 1u); break; } }
    }
    nloc = mine > 0u ? mine : 1u; nx = cnt > 0u ? cnt : 1u;
}
__device__ __forceinline__ void xcd_barrier(const XcdBarrier& b) {
    asm volatile("s_waitcnt vmcnt(0)" ::: "memory");
    __syncthreads();
    if (threadIdx.x == 0) {
        unsigned* bar = b.bar;
        __builtin_amdgcn_s_waitcnt(0);
        unsigned nloc = b.st[0], nx = b.st[1];
        if (nloc == 0u) { xcd_barrier_complete(bar, b.x, nloc, nx); b.st[0] = nloc; b.st[1] = nx; }
        const unsigned old = xb_add(&bar[XB_XSUB(b.x)], 1u);
        const unsigned gen = old / nloc;
        if (old + 1u == (gen + 1u) * nloc) {
            __builtin_amdgcn_fence(__ATOMIC_RELEASE, "agent");
            asm volatile("s_waitcnt vmcnt(0)" ::: "memory");
            const unsigned og = xb_add(&bar[XB_TOP], 1u);
            const unsigned tg = og / nx;
            if (og + 1u == (tg + 1u) * nx) xb_add(&bar[XB_TOPGEN], 1u);
            else XB_SPIN(xb_ld(&bar[XB_TOPGEN]) == tg, bar);
            __builtin_amdgcn_fence(__ATOMIC_ACQUIRE, "agent");
            xb_add(&bar[XB_XGEN(b.x)], 1u);
            asm volatile("s_waitcnt vmcnt(0)" ::: "memory");
        } else {
            XB_SPIN(xb_ld(&bar[XB_XGEN(b.x)]) == gen, bar);
            __builtin_amdgcn_fence(__ATOMIC_ACQUIRE, "agent");
            asm volatile("s_waitcnt vmcnt(0)" ::: "memory");
        }
    }
    __syncthreads();
}

struct RowOrder {
    int nM, nN, nwg, G, c; bool skipctx; int nextra;
    const unsigned* ctxrdy = nullptr; unsigned ctxneed = 0;
    __device__ void init(int nM_, int nN_, int G_, int c_, bool skip, int nextra_ = 0) { nM = nM_; nN = nN_; nwg = nM * nN; G = G_; c = c_; skipctx = skip; nextra = nextra_; }
    __device__ bool next(int i, pg8::Unit& u) const {
        const long L = (long)i * G + c; if (L >= nwg + nextra) return false;
        if (L >= nwg) { const int r = (int)L - nwg, t = r >> 1; u.pm = (r & 1) ? 17 : 0; u.pn = t < 12 ? 4 + t : 28 + t; return true; }
        int wgid = (int)L; { const int q = nwg / pg8::NXCD, r = nwg % pg8::NXCD, xcd = wgid % pg8::NXCD, off = wgid / pg8::NXCD; wgid = (xcd < r ? xcd * (q + 1) : r * (q + 1) + (xcd - r) * q) + off; }
        const int nig = pg8::WGM * nN, gid = wgid / nig, fm = gid * pg8::WGM, gsz = (nM - fm) < pg8::WGM ? (nM - fm) : pg8::WGM;
        int pm = fm + ((wgid % nig) % gsz); u.pn = (wgid % nig) / gsz;
        if (skipctx) pm = pm + 1 + (pm >= 16 ? 1 : 0);
        u.pm = pm; return true;
    }
    __device__ __forceinline__ void a_ready(const pg8::Unit& u) const {
        if (ctxrdy != nullptr && (u.pm == 0 || u.pm == 17)) {
            if (threadIdx.x < 64) { unsigned sp = 0u;
                while (__hip_atomic_load(ctxrdy, __ATOMIC_RELAXED, __HIP_MEMORY_SCOPE_AGENT) < ctxneed) { __builtin_amdgcn_s_sleep(2); if (++sp > (1u << 22)) break; }
                __builtin_amdgcn_fence(__ATOMIC_ACQUIRE, "agent");
                asm volatile("s_waitcnt vmcnt(0)" ::: "memory"); }
            asm volatile("" ::: "memory"); __builtin_amdgcn_s_barrier(); asm volatile("" ::: "memory");
        }
    }
    __device__ __forceinline__ void done(const pg8::Unit&) const {}
};

struct EpiIn {
    static constexpr bool PERM = true, AFTER_DRAIN = false;
    bf16 *mq, *mk, *mv, *mg, *aq, *ak, *av, *asz;
    __device__ __forceinline__ void operator()(const f32x4 (&acc)[2][2][4][2], const pg8::Unit& u, int wr, int wc, int fr, int fq) const {
        const int row0 = u.pm * 256 + wr * 64 + fr, c8 = wc * 32 + 8 * fq, pn = u.pn;
        if (pn >= 16 && pn < 32) {
            bf16* base = mg + (size_t)row0 * MVW + (pn - 16) * 128 + c8;
#pragma unroll
            for (int ai = 0; ai < 2; ++ai)
#pragma unroll
                for (int m = 0; m < 4; ++m) {
                    float gv[8];
#pragma unroll
                    for (int n = 0; n < 2; ++n)
#pragma unroll
                        for (int e = 0; e < 4; ++e) { const float o = acc[ai][0][m][n][e], z = acc[ai][1][m][n][e]; gv[4 * n + e] = sigmoidf_fast(o) * z * sigmoidf_fast(z); }
                    u32x4 w; w.x = cvtpk(gv[0], gv[1]); w.y = cvtpk(gv[2], gv[3]); w.z = cvtpk(gv[4], gv[5]); w.w = cvtpk(gv[6], gv[7]);
                    stg<u32x4>(base + (size_t)(ai * 128 + m * 16) * MVW, w);
                }
            return;
        }
        bf16* dst; int ld, cb; float sc = 1.f; bool act = false;
        if (pn < 4)       { dst = mq; ld = MQW; cb = pn * 256; sc = 0.0625f; }
        else if (pn < 8)  { dst = mk; ld = MQW; cb = (pn - 4) * 256; }
        else if (pn < 16) { dst = mv; ld = MVW; cb = (pn - 8) * 256; }
        else if (pn < 40) { dst = aq; ld = AQW; cb = (pn - 32) * 256; }
        else if (pn < 42) { dst = ak; ld = AKW; cb = (pn - 40) * 256; }
        else if (pn < 44) { dst = av; ld = AKW; cb = (pn - 42) * 256; }
        else              { dst = asz; ld = AQW; cb = (pn - 44) * 256; act = true; }
        bf16* base = dst + (size_t)row0 * ld + cb + c8;
#pragma unroll
        for (int ai = 0; ai < 2; ++ai)
#pragma unroll
            for (int m = 0; m < 4; ++m)
#pragma unroll
                for (int bj = 0; bj < 2; ++bj) {
                    f32x4 v0 = acc[ai][bj][m][0] * sc, v1 = acc[ai][bj][m][1] * sc;
                    if (act) {
#pragma unroll
                        for (int e = 0; e < 4; ++e) { v0[e] = v0[e] * sigmoidf_fast(v0[e]); v1[e] = v1[e] * sigmoidf_fast(v1[e]); }
                    }
                    u32x4 w; w.x = cvtpk(v0[0], v0[1]); w.y = cvtpk(v0[2], v0[3]); w.z = cvtpk(v1[0], v1[1]); w.w = cvtpk(v1[2], v1[3]);
                    stg<u32x4>(base + (size_t)(ai * 128 + m * 16) * ld + bj * 128, w);
                }
    }
};

struct EpiOut {
    static constexpr bool PERM = true, AFTER_DRAIN = false;
    int layer; const float* x; const float* ctx; const float* xr1_in; float* xr1_out; float* out; const float* mod; const float* bmod;
    __device__ __forceinline__ void operator()(const f32x4 (&acc)[2][2][4][2], const pg8::Unit& u, int wr, int wc, int fr, int fq) const {
        const int b = u.pm / 17, tl = u.pm % 17;
        const int rloc = wr * 64 + fr;
        const float* rs; float* os;
        if (layer == 0) {
            rs = (tl == 0) ? ctx + (size_t)(b * CTXL) * DM : x + (size_t)(b * SEQ + (tl - 1) * 256) * DM;
            os = MK_XR16 ? (float*)((bf16*)xr1_out + (size_t)(u.pm * 256) * DM) : xr1_out + (size_t)(u.pm * 256) * DM;
        } else {
            rs = MK_XR16 ? (const float*)((const bf16*)xr1_in + (size_t)(u.pm * 256) * DM) : xr1_in + (size_t)(u.pm * 256) * DM;
            os = out + (size_t)(b * SEQ + (tl - 1) * 256) * DM;
        }
        const int mr = (tl == 0) ? 2 : b;
        const float* gp = mod + (size_t)mr * MODW + 2 * DM; const float* gb = bmod + 2 * DM;
        const int col0 = u.pn * 256 + wc * 32 + 8 * fq;
        f32x4 gv[2][2];
#pragma unroll
        for (int bj = 0; bj < 2; ++bj)
#pragma unroll
            for (int n = 0; n < 2; ++n) gv[bj][n] = ldg<f32x4>(gp + col0 + bj * 128 + 4 * n) + ldg<f32x4>(gb + col0 + bj * 128 + 4 * n);
#pragma unroll
        for (int ai = 0; ai < 2; ++ai)
#pragma unroll
            for (int m = 0; m < 4; ++m) {
                const size_t ro = (size_t)(rloc + ai * 128 + m * 16) * DM + col0;
#pragma unroll
                for (int bj = 0; bj < 2; ++bj)
#pragma unroll
                    for (int n = 0; n < 2; ++n) {
                        f32x4 r;
                        if (MK_XR16 && layer != 0) { const u32x2 w = ldg<u32x2>((const bf16*)rs + ro + bj * 128 + 4 * n); r[0] = bflo(w.x); r[1] = bfhi(w.x); r[2] = bflo(w.y); r[3] = bfhi(w.y); }
                        else r = ldg<f32x4>(rs + ro + bj * 128 + 4 * n);
                        const f32x4 y = r + gv[bj][n] * acc[ai][bj][m][n];
                        if (MK_XR16 && layer == 0) { u32x2 w; w.x = cvtpk(y[0], y[1]); w.y = cvtpk(y[2], y[3]); stg<u32x2>((bf16*)os + ro + bj * 128 + 4 * n, w); }
                        else stg<f32x4>(os + ro + bj * 128 + 4 * n, y);
                    }
            }
    }
};

struct PanelOrder {
    int c, call;
    __device__ bool next(int i, pg8::Unit& u) const { if (i > 0) return false; int pm = (c >> 4) + 16 * call; u.pm = pm + 1 + (pm >= 16 ? 1 : 0); u.pn = c & 15; return true; }
    __device__ __forceinline__ void a_ready(const pg8::Unit&) const {}
    __device__ __forceinline__ void done(const pg8::Unit&) const {}
};
struct EpiOutNorm {
    static constexpr bool PERM = true, AFTER_DRAIN = true;
    const bf16* xr1_in; float* out; const float* mod; const float* bmod; const float* gfin; float* slots; unsigned* cnt;
    __device__ __forceinline__ void operator()(const f32x4 (&)[2][2][4][2], const pg8::Unit&, int, int, int, int) const {}
    __device__ __forceinline__ void fused(f32x4 (&acc)[2][2][4][2], const pg8::Unit& u, int wr, int wc, int fr, int fq, LAS unsigned char* lds, int wid, int lane) const {
        const int b = u.pm / 17, tl = u.pm % 17, tid = wid * 64 + lane;
        const int rloc = wr * 64 + fr;
        const bf16* rs = xr1_in + (size_t)(u.pm * 256) * DM; float* os = out + (size_t)(b * SEQ + (tl - 1) * 256) * DM;
        const float* gp = mod + (size_t)b * MODW + 2 * DM; const float* gb = bmod + 2 * DM;
        const int col0 = u.pn * 256 + wc * 32 + 8 * fq;
        LAS float* part = (LAS float*)lds; LAS float* rst = part + 1024;
        { f32x4 gv[2][2];
#pragma unroll
          for (int bj = 0; bj < 2; ++bj)
#pragma unroll
              for (int n = 0; n < 2; ++n) gv[bj][n] = ldg<f32x4>(gp + col0 + bj * 128 + 4 * n) + ldg<f32x4>(gb + col0 + bj * 128 + 4 * n);
#pragma unroll
          for (int ai = 0; ai < 2; ++ai)
#pragma unroll
              for (int m = 0; m < 4; ++m) {
                  const size_t ro = (size_t)(rloc + ai * 128 + m * 16) * DM + col0; float sq = 0.f;
#pragma unroll
                  for (int bj = 0; bj < 2; ++bj)
#pragma unroll
                      for (int n = 0; n < 2; ++n) {
                          const u32x2 w = ldg<u32x2>(rs + ro + bj * 128 + 4 * n); f32x4 r; r[0] = bflo(w.x); r[1] = bfhi(w.x); r[2] = bflo(w.y); r[3] = bfhi(w.y);
                          const f32x4 y = r + gv[bj][n] * acc[ai][bj][m][n]; acc[ai][bj][m][n] = y;
                          sq += (y[0] * y[0] + y[1] * y[1]) + (y[2] * y[2] + y[3] * y[3]); }
                  sq += shl_xor(sq, 16, lane); sq += shl_xor(sq, 32, lane);
                  if (fq == 0) part[(rloc + ai * 128 + m * 16) * 4 + wc] = sq; } }
        __syncthreads();
        float* slot = slots + ((size_t)u.pm * 16 + u.pn) * 256;
        if (tid < 256) stg_wt4(slot + tid, __float_as_uint((part[tid * 4] + part[tid * 4 + 1]) + (part[tid * 4 + 2] + part[tid * 4 + 3])));
        asm volatile("s_waitcnt vmcnt(0)" ::: "memory");
        __syncthreads();
        if (wid == 0) {
            if (lane == 0) __hip_atomic_fetch_add(cnt + u.pm, 1u, __ATOMIC_RELAXED, __HIP_MEMORY_SCOPE_AGENT);
            unsigned sp = 0u;
            while (__hip_atomic_load(cnt + u.pm, __ATOMIC_RELAXED, __HIP_MEMORY_SCOPE_AGENT) < 16u) { __builtin_amdgcn_s_sleep(2); if (++sp > (1u << 22)) break; }
            __builtin_amdgcn_fence(__ATOMIC_ACQUIRE, "agent"); }
        asm volatile("s_waitcnt vmcnt(0)" ::: "memory");
        __syncthreads();
        if (tid < 256) { const float* sp_ = slots + (size_t)u.pm * 16 * 256 + tid; float t = 0.f;
#pragma unroll
            for (int q = 0; q < 16; ++q) t += ldg<float>(sp_ + q * 256);
            rst[tid] = rsqrtf(t * (1.f / DM) + EPS); }
        __syncthreads();
        { f32x4 gf[2][2];
#pragma unroll
          for (int bj = 0; bj < 2; ++bj)
#pragma unroll
              for (int n = 0; n < 2; ++n) gf[bj][n] = ldg<f32x4>(gfin + col0 + bj * 128 + 4 * n);
#pragma unroll
          for (int ai = 0; ai < 2; ++ai)
#pragma unroll
              for (int m = 0; m < 4; ++m) {
                  const size_t ro = (size_t)(rloc + ai * 128 + m * 16) * DM + col0; const float rr = rst[rloc + ai * 128 + m * 16];
#pragma unroll
                  for (int bj = 0; bj < 2; ++bj)
#pragma unroll
                      for (int n = 0; n < 2; ++n) stg<f32x4>(os + ro + bj * 128 + 4 * n, acc[ai][bj][m][n] * rr * gf[bj][n]); } }
        __syncthreads();
    }
};

struct EpiOutNormL0 {
    static constexpr bool PERM = true, AFTER_DRAIN = true;
    const float* x; const float* mod0; const float* bmod0; bf16* xr1; bf16* xn; const float* mod1; const float* bmod1; const float* gn1; float* slots; unsigned* cnt;
    __device__ __forceinline__ void operator()(const f32x4 (&)[2][2][4][2], const pg8::Unit&, int, int, int, int) const {}
    __device__ __forceinline__ void fused(f32x4 (&acc)[2][2][4][2], const pg8::Unit& u, int wr, int wc, int fr, int fq, LAS unsigned char* lds, int wid, int lane) const {
        const int b = u.pm / 17, tl = u.pm % 17, tid = wid * 64 + lane;
        const int rloc = wr * 64 + fr;
        const float* rs = x + (size_t)(b * SEQ + (tl - 1) * 256) * DM;
        const float* gp = mod0 + (size_t)b * MODW + 2 * DM; const float* gb = bmod0 + 2 * DM;
        const int col0 = u.pn * 256 + wc * 32 + 8 * fq;
        LAS float* part = (LAS float*)lds; LAS float* rst = part + 1024;
        { f32x4 gv[2][2];
#pragma unroll
          for (int bj = 0; bj < 2; ++bj)
#pragma unroll
              for (int n = 0; n < 2; ++n) gv[bj][n] = ldg<f32x4>(gp + col0 + bj * 128 + 4 * n) + ldg<f32x4>(gb + col0 + bj * 128 + 4 * n);
#pragma unroll
          for (int ai = 0; ai < 2; ++ai)
#pragma unroll
              for (int m = 0; m < 4; ++m) {
                  const size_t ro = (size_t)(rloc + ai * 128 + m * 16) * DM + col0; float sq = 0.f;
#pragma unroll
                  for (int bj = 0; bj < 2; ++bj)
#pragma unroll
                      for (int n = 0; n < 2; ++n) {
                          const f32x4 y = ldg<f32x4>(rs + ro + bj * 128 + 4 * n) + gv[bj][n] * acc[ai][bj][m][n]; acc[ai][bj][m][n] = y;
                          sq += (y[0] * y[0] + y[1] * y[1]) + (y[2] * y[2] + y[3] * y[3]);
                          u32x2 w; w.x = cvtpk(y[0], y[1]); w.y = cvtpk(y[2], y[3]); stg<u32x2>(xr1 + (size_t)(u.pm * 256) * DM + ro + bj * 128 + 4 * n, w); }
                  sq += shl_xor(sq, 16, lane); sq += shl_xor(sq, 32, lane);
                  if (fq == 0) part[(rloc + ai * 128 + m * 16) * 4 + wc] = sq; } }
        __syncthreads();
        float* slot = slots + ((size_t)u.pm * 16 + u.pn) * 256;
        if (tid < 256) stg_wt4(slot + tid, __float_as_uint((part[tid * 4] + part[tid * 4 + 1]) + (part[tid * 4 + 2] + part[tid * 4 + 3])));
        asm volatile("s_waitcnt vmcnt(0)" ::: "memory");
        __syncthreads();
        if (wid == 0) {
            if (lane == 0) __hip_atomic_fetch_add(cnt + u.pm, 1u, __ATOMIC_RELAXED, __HIP_MEMORY_SCOPE_AGENT);
            unsigned sp = 0u;
            while (__hip_atomic_load(cnt + u.pm, __ATOMIC_RELAXED, __HIP_MEMORY_SCOPE_AGENT) < 16u) { __builtin_amdgcn_s_sleep(2); if (++sp > (1u << 22)) break; }
            __builtin_amdgcn_fence(__ATOMIC_ACQUIRE, "agent"); }
        asm volatile("s_waitcnt vmcnt(0)" ::: "memory");
        __syncthreads();
        if (tid < 256) { const float* sp_ = slots + (size_t)u.pm * 16 * 256 + tid; float t = 0.f;
#pragma unroll
            for (int q = 0; q < 16; ++q) t += ldg<float>(sp_ + q * 256);
            rst[tid] = rsqrtf(t * (1.f / DM) + EPS); }
        __syncthreads();
        { const float* mp = mod1 + (size_t)b * MODW;
          f32x4 A[2][2], B[2][2];
#pragma unroll
          for (int bj = 0; bj < 2; ++bj)
#pragma unroll
              for (int n = 0; n < 2; ++n) { const int k = col0 + bj * 128 + 4 * n;
                  A[bj][n] = ldg<f32x4>(gn1 + k) * (ldg<f32x4>(mp + DM + k) + ldg<f32x4>(bmod1 + DM + k) + 1.0f); B[bj][n] = ldg<f32x4>(mp + k) + ldg<f32x4>(bmod1 + k); }
#pragma unroll
          for (int ai = 0; ai < 2; ++ai)
#pragma unroll
              for (int m = 0; m < 4; ++m) {
                  const size_t ro = (size_t)(u.pm * 256 + rloc + ai * 128 + m * 16) * DM + col0; const float rr = rst[rloc + ai * 128 + m * 16];
#pragma unroll
                  for (int bj = 0; bj < 2; ++bj)
#pragma unroll
                      for (int n = 0; n < 2; ++n) { const f32x4 h = acc[ai][bj][m][n] * rr * A[bj][n] + B[bj][n];
                          u32x2 w; w.x = cvtpk(h[0], h[1]); w.y = cvtpk(h[2], h[3]); stg<u32x2>(xn + ro + bj * 128 + 4 * n, w); } } }
        __syncthreads();
    }
};

struct KSplitOrder {
    int c;
    __device__ bool next(int i, pg8::Unit& u) const { if (i > 0) return false; const int unit = c >> 3; u.pm = (unit >> 4) * 17; u.pn = unit & 15; return true; }
    __device__ __forceinline__ void a_ready(const pg8::Unit&) const {}
    __device__ __forceinline__ void done(const pg8::Unit&) const {}
};
struct EpiPart {
    static constexpr bool PERM = true, AFTER_DRAIN = false;
    float* part; int ks;
    __device__ __forceinline__ void operator()(const f32x4 (&acc)[2][2][4][2], const pg8::Unit& u, int wr, int wc, int fr, int fq) const {
        float* os = part + ((size_t)ks * (NBATCH * CTXL) + (size_t)(u.pm / 17) * CTXL) * DM;
        const int col0 = u.pn * 256 + wc * 32 + 8 * fq, rloc = wr * 64 + fr;
#pragma unroll
        for (int ai = 0; ai < 2; ++ai)
#pragma unroll
            for (int m = 0; m < 4; ++m) { float* rp = os + (size_t)(rloc + ai * 128 + m * 16) * DM + col0;
#pragma unroll
                for (int bj = 0; bj < 2; ++bj)
#pragma unroll
                    for (int n = 0; n < 2; ++n) stg<f32x4>(rp + bj * 128 + 4 * n, acc[ai][bj][m][n]); }
    }
};

namespace att {
constexpr int D = 128, NW = 8, QBLK = 32, KVBLK = 64;
constexpr float SCALE = 0.088388347648318440f;
constexpr float THR = 8.f;
constexpr int LDQ = AQW, LDK = AKW;
constexpr size_t SHM_V = KVBLK * D * 2, SHM_K = KVBLK * D * 2, SHM_ATTN = 2 * SHM_V + 2 * SHM_K + NW * 64 * 4;
#define KSWZ(row, colB) ((row) * 256 + ((colB) ^ (((row) & 7) << 4)))
#define SBAR() __builtin_amdgcn_sched_barrier(0)
__device__ __forceinline__ int crow(int r, int hi) { return (r & 3) + 8 * (r >> 2) + 4 * hi; }
__device__ __forceinline__ unsigned cvtpkv(float lo, float hi) { unsigned r; asm volatile("v_cvt_pk_bf16_f32 %0, %1, %2" : "=v"(r) : "v"(lo), "v"(hi)); return r; }
template <bool FIXM> __device__ __forceinline__ void partialSM(f32x16& p0, f32x16& p1, float& m_reg, float& mn, float& alpha) {
  constexpr float C = SCALE * 1.4426950408889634f;
  if constexpr (FIXM) {
    mn = m_reg; alpha = 1.f; const float mnC0 = -m_reg * C;
#pragma unroll
    for (int r = 0; r < 16; ++r) p0[r] = fmaf(p0[r], C, mnC0);
#pragma unroll
    for (int r = 0; r < 16; ++r) p1[r] = fmaf(p1[r], C, mnC0);
#pragma unroll
    for (int r = 0; r < 16; ++r) p0[r] = __builtin_amdgcn_exp2f(p0[r]);
    return;
  }
  float pmax = p0[0];
#pragma unroll
  for (int r = 1; r < 16; ++r) pmax = fmaxf(pmax, p0[r]);
#pragma unroll
  for (int r = 0; r < 16; ++r) pmax = fmaxf(pmax, p1[r]);
  { auto rr = __builtin_amdgcn_permlane32_swap(__float_as_uint(pmax), __float_as_uint(pmax), false, false);
    pmax = fmaxf(__uint_as_float(rr[0]), __uint_as_float(rr[1])); }
  if (__builtin_expect(__all(pmax - m_reg <= THR / SCALE), 1)) { mn = m_reg; alpha = 1.f; }
  else { mn = fmaxf(m_reg, pmax); alpha = __builtin_amdgcn_exp2f((m_reg - mn) * C); m_reg = mn; }
  float mnC = -mn * C;
#pragma unroll
  for (int r = 0; r < 16; ++r) p0[r] = fmaf(p0[r], C, mnC);
#pragma unroll
  for (int r = 0; r < 16; ++r) p1[r] = fmaf(p1[r], C, mnC);
#pragma unroll
  for (int r = 0; r < 16; ++r) p0[r] = __builtin_amdgcn_exp2f(p0[r]);
}
__device__ __forceinline__ void finishSM(f32x16& p0, f32x16& p1, float alpha, float& l_reg, bf16x8& pa0, bf16x8& pa1, bf16x8& pa2, bf16x8& pa3) {
#pragma unroll
  for (int r = 0; r < 16; ++r) p1[r] = __builtin_amdgcn_exp2f(p1[r]);
  float ps = 0;
#pragma unroll
  for (int r = 0; r < 16; ++r) ps += p0[r];
#pragma unroll
  for (int r = 0; r < 16; ++r) ps += p1[r];
  { auto rr = __builtin_amdgcn_permlane32_swap(__float_as_uint(ps), __float_as_uint(ps), false, false);
    ps = __uint_as_float(rr[0]) + __uint_as_float(rr[1]); }
  l_reg = l_reg * alpha + ps;
#define PK4(P, BASE, OUT) do { unsigned a0 = cvtpkv(P[BASE + 0], P[BASE + 1]), a1 = cvtpkv(P[BASE + 2], P[BASE + 3]);   \
    unsigned b0 = cvtpkv(P[BASE + 4], P[BASE + 5]), b1 = cvtpkv(P[BASE + 6], P[BASE + 7]);                              \
    auto r0 = __builtin_amdgcn_permlane32_swap(a0, b0, false, false); auto r1 = __builtin_amdgcn_permlane32_swap(a1, b1, false, false); \
    u32x4 w = {r0[0], r1[0], r0[1], r1[1]}; OUT = *reinterpret_cast<bf16x8*>(&w); } while (0)
  PK4(p0, 0, pa0); PK4(p0, 8, pa1); PK4(p1, 0, pa2); PK4(p1, 8, pa3);
#undef PK4
}
__device__ __forceinline__ void qkt(f32x16& p0, f32x16& p1, const bf16* Ks, const bf16x8* qr, int r32, int hi) {
  p0 = f32x16{}; p1 = f32x16{};
#pragma unroll
  for (int d0 = 0; d0 < 8; ++d0) { int cb = (d0 * 16 + hi * 8) * 2;
    bf16x8 b0 = *reinterpret_cast<const bf16x8*>((const char*)Ks + KSWZ(r32, cb));
    bf16x8 b1 = *reinterpret_cast<const bf16x8*>((const char*)Ks + KSWZ(32 + r32, cb));
    p0 = __builtin_amdgcn_mfma_f32_32x32x16_bf16(b0, qr[d0], p0, 0, 0, 0);
    p1 = __builtin_amdgcn_mfma_f32_32x32x16_bf16(b1, qr[d0], p1, 0, 0, 0); }
}
__device__ __forceinline__ int v_st(int k, int c) { const int kk = (k & ~0xC) | ((k & 4) << 1) | ((k & 8) >> 1); return ((kk >> 3) * 4 + (c >> 5)) * 512 + ((kk & 7) * 32 + (c & 31)) * 2; }
__device__ __forceinline__ int v_rd_base(int lane) { return ((lane & 3) << 3) | (((lane >> 2) & 3) << 6) | (((lane >> 4) & 1) << 5) | (((lane >> 5) & 1) << 8); }
constexpr int v_rd_off(int d0, int ks, int half) { return d0 * 512 + ks * 4096 + half * 2048; }
template <int OFF> __device__ __forceinline__ s16x4 tr_read(int vb) {
  s16x4 r; asm volatile("ds_read_b64_tr_b16 %0, %1 offset:%2" : "=&v"(r) : "v"(vb), "i"(OFF) : "memory"); return r;
}
template <int D0> __device__ __forceinline__ void pv_one(f32x16& od, int vb, bf16x8 pa0, bf16x8 pa1, bf16x8 pa2, bf16x8 pa3) {
  const s16x4 l0 = tr_read<v_rd_off(D0, 0, 0)>(vb), h0 = tr_read<v_rd_off(D0, 0, 1)>(vb), l1 = tr_read<v_rd_off(D0, 1, 0)>(vb), h1 = tr_read<v_rd_off(D0, 1, 1)>(vb);
  const s16x4 l2 = tr_read<v_rd_off(D0, 2, 0)>(vb), h2 = tr_read<v_rd_off(D0, 2, 1)>(vb), l3 = tr_read<v_rd_off(D0, 3, 0)>(vb), h3 = tr_read<v_rd_off(D0, 3, 1)>(vb);
  asm volatile("s_waitcnt lgkmcnt(0)" ::: "memory"); SBAR();
#define PKV(L, H) (bf16x8){L[0], L[1], L[2], L[3], H[0], H[1], H[2], H[3]}
  od = __builtin_amdgcn_mfma_f32_32x32x16_bf16(pa0, PKV(l0, h0), od, 0, 0, 0);
  od = __builtin_amdgcn_mfma_f32_32x32x16_bf16(pa1, PKV(l1, h1), od, 0, 0, 0);
  od = __builtin_amdgcn_mfma_f32_32x32x16_bf16(pa2, PKV(l2, h2), od, 0, 0, 0);
  od = __builtin_amdgcn_mfma_f32_32x32x16_bf16(pa3, PKV(l3, h3), od, 0, 0, 0);
#undef PKV
}
__device__ __forceinline__ void pv_d0(f32x16* o, int vb, bf16x8 pa0, bf16x8 pa1, bf16x8 pa2, bf16x8 pa3) {
  pv_one<0>(o[0], vb, pa0, pa1, pa2, pa3); pv_one<1>(o[1], vb, pa0, pa1, pa2, pa3); pv_one<2>(o[2], vb, pa0, pa1, pa2, pa3); pv_one<3>(o[3], vb, pa0, pa1, pa2, pa3);
}
template <bool FIXM> __device__ __forceinline__ void attn_dense_body(const bf16* __restrict__ Qb, const bf16* __restrict__ Kh, const bf16* __restrict__ Vh,
                                                const bf16* __restrict__ Zb, bf16* __restrict__ Yb, int seq, char* lds, const int tid,
                                                float* part, unsigned* ticket, int pidx, volatile LAS unsigned* bcast, const float mfix, const bool skip_epi = false) {
  const int wid = tid >> 6, lane = tid & 63, r32 = lane & 31, hi = lane >> 5;
  bf16* V_lds = (bf16*)lds; bf16* K_lds = (bf16*)(lds + 2 * SHM_V);
  float* ws = (float*)(lds + 2 * SHM_V + 2 * SHM_K) + wid * 64; float* li_l = ws; float* al_l = ws + 32;
  float m_reg = FIXM ? mfix : -1e30f, l_reg = 0; f32x16 o[4] = {}; bf16x8 qr[8];
  const bf16* Qw = Qb + (long)(wid * QBLK + r32) * LDQ + hi * 8;
#pragma unroll
  for (int d0 = 0; d0 < 8; ++d0) qr[d0] = ldg<bf16x8>(Qw + d0 * 16);
  const int sr = tid >> 4, sc = (tid & 15) * 8, vst0 = v_st(sr, sc), vst1 = v_st(32 + sr, sc);
  const int vb0 = (int)(uintptr_t)V_lds + v_rd_base(lane);
  struct { bf16x8 vs0, vs1, ks0, ks1; } sr_[2];
#define SLOAD(i, k0) do { sr_[i].vs0 = ldg<bf16x8>(&Vh[(long)((k0) + sr) * LDK + sc]); sr_[i].vs1 = ldg<bf16x8>(&Vh[(long)((k0) + 32 + sr) * LDK + sc]); \
    sr_[i].ks0 = ldg<bf16x8>(&Kh[(long)((k0) + sr) * LDK + sc]); sr_[i].ks1 = ldg<bf16x8>(&Kh[(long)((k0) + 32 + sr) * LDK + sc]); } while (0)
#define SWRITE(b, i) do { *(bf16x8*)((char*)V_lds + (b) * SHM_V + vst0) = sr_[i].vs0;          \
    *(bf16x8*)((char*)V_lds + (b) * SHM_V + vst1) = sr_[i].vs1; int kc = sc * 2;               \
    *(bf16x8*)((char*)K_lds + (b) * SHM_K + KSWZ(sr, kc)) = sr_[i].ks0;                       \
    *(bf16x8*)((char*)K_lds + (b) * SHM_K + KSWZ(32 + sr, kc)) = sr_[i].ks1; } while (0)
#define SWAIT() asm volatile("s_waitcnt vmcnt(4)" ::: "memory")
#define RESC(a) do { if (!FIXM && __any((a) < 1.f)) { if (hi == 0) al_l[r32] = (a); asm volatile("s_waitcnt lgkmcnt(0)" ::: "memory"); \
    _Pragma("unroll") for (int d = 0; d < 4; ++d) _Pragma("unroll") for (int r = 0; r < 16; ++r) o[d][r] *= al_l[crow(r, hi)]; } } while (0)
  f32x16 pA0, pA1, pB0, pB1; float mnA, mnB, alA, alB; bf16x8 pa0, pa1, pa2, pa3; const int NT = seq / KVBLK;
  constexpr int SE = 0, SO = 1;
  SLOAD(SE, 0); asm volatile("s_waitcnt vmcnt(0)" ::: "memory"); SWRITE(0, SE); __syncthreads();
  qkt(pA0, pA1, K_lds, qr, r32, hi); partialSM<FIXM>(pA0, pA1, m_reg, mnA, alA);
  SLOAD(SO, KVBLK); if (2 < NT) SLOAD(SE, 2 * KVBLK);
  SWAIT(); SWRITE(1, SO); __syncthreads();
  for (int j = 1; j + 1 < NT; j += 2) {
    SBAR(); qkt(pB0, pB1, (bf16*)((char*)K_lds + SHM_K), qr, r32, hi);
    finishSM(pA0, pA1, alA, l_reg, pa0, pa1, pa2, pa3); SBAR();
    SLOAD(SO, (j + 2) * KVBLK); SBAR();
    pv_d0(o, vb0, pa0, pa1, pa2, pa3); partialSM<FIXM>(pB0, pB1, m_reg, mnB, alB);
    __syncthreads(); SWAIT(); SWRITE(0, SE);
    RESC(alB); __syncthreads();
    SBAR(); qkt(pA0, pA1, K_lds, qr, r32, hi);
    finishSM(pB0, pB1, alB, l_reg, pa0, pa1, pa2, pa3); SBAR();
    if (j + 3 < NT) SLOAD(SE, (j + 3) * KVBLK); SBAR();
    pv_d0(o, vb0 + (int)SHM_V, pa0, pa1, pa2, pa3); partialSM<FIXM>(pA0, pA1, m_reg, mnA, alA);
    __syncthreads(); SWAIT(); SWRITE(1, SO);
    RESC(alA); __syncthreads();
  }
  SBAR(); qkt(pB0, pB1, (bf16*)((char*)K_lds + SHM_K), qr, r32, hi);
  finishSM(pA0, pA1, alA, l_reg, pa0, pa1, pa2, pa3); SBAR();
  pv_d0(o, vb0, pa0, pa1, pa2, pa3); partialSM<FIXM>(pB0, pB1, m_reg, mnB, alB);
  __syncthreads(); RESC(alB);
  finishSM(pB0, pB1, alB, l_reg, pa0, pa1, pa2, pa3); SBAR();
  pv_d0(o, vb0 + (int)SHM_V, pa0, pa1, pa2, pa3);
  if (part != nullptr) {
    constexpr float C = SCALE * 1.4426950408889634f;
    float* mine = part + (size_t)pidx * (66 * 512) + tid;
    asm volatile("" : "+v"(mine) :: "memory"); SBAR();
#pragma unroll
    for (int d0 = 0; d0 < 4; ++d0)
#pragma unroll
      for (int r = 0; r < 16; ++r) stg_wt4(mine + (d0 * 16 + r) * 512, __float_as_uint(o[d0][r]));
    stg_wt4(mine + 64 * 512, __float_as_uint(m_reg)); stg_wt4(mine + 65 * 512, __float_as_uint(l_reg));
    asm volatile("s_waitcnt vmcnt(0)" ::: "memory");
    __syncthreads();
    if (tid == 0) bcast[0] = __hip_atomic_fetch_add(ticket, 1u, __ATOMIC_RELAXED, __HIP_MEMORY_SCOPE_AGENT);
    __syncthreads();
    const unsigned tk = bcast[0];
    __syncthreads();
    if (tk != (unsigned)(NPART - 1)) return;
    if (wid == 0) __builtin_amdgcn_fence(__ATOMIC_ACQUIRE, "agent");
    asm volatile("s_waitcnt vmcnt(0)" ::: "memory");
    __syncthreads();
#pragma unroll 1
    for (int sft = 1; sft < NPART; ++sft) {
      const float* other = part + (size_t)((pidx + sft) & (NPART - 1)) * (66 * 512) + tid;
      asm volatile("" : "+v"(other) :: "memory");
      const float m2 = ldg<float>(other + 64 * 512), l2 = ldg<float>(other + 65 * 512);
      const float mm = fmaxf(m_reg, m2), a1 = __builtin_amdgcn_exp2f((m_reg - mm) * C), a2 = __builtin_amdgcn_exp2f((m2 - mm) * C);
      l_reg = l_reg * a1 + l2 * a2; m_reg = mm;
      if (hi == 0) { li_l[r32] = a1; al_l[r32] = a2; } asm volatile("s_waitcnt lgkmcnt(0)" ::: "memory");
#pragma unroll
      for (int r = 0; r < 16; ++r) { const float f1 = li_l[crow(r, hi)], f2 = al_l[crow(r, hi)];
#pragma unroll
        for (int d0 = 0; d0 < 4; ++d0) o[d0][r] = o[d0][r] * f1 + ldg<float>(other + (d0 * 16 + r) * 512) * f2;
        if ((r & 3) == 3) { asm volatile("" ::: "memory"); SBAR(); } }
      asm volatile("s_waitcnt lgkmcnt(0)" ::: "memory"); SBAR();
    }
  }
  if (hi == 0) li_l[r32] = l_reg; asm volatile("s_waitcnt lgkmcnt(0)" ::: "memory");
  float rli[16];
#pragma unroll
  for (int r = 0; r < 16; ++r) rli[r] = __builtin_amdgcn_rcpf(li_l[crow(r, hi)]);
  bf16* Yl = Yb + (long)(wid * QBLK + 4 * hi) * DM + r32; const bf16* Zl = Zb + (long)(wid * QBLK + 4 * hi) * AQW + r32;
  asm volatile("" : "+v"(Yl), "+v"(Zl) :: "memory"); SBAR();
#if MK_PER_PHASE
  if (skip_epi) return;
#endif
#if MK_EPILDS
  (void)Yl; (void)Zl;
  { float* ep = (float*)(lds + SHM_ATTN) + wid * 2048;
    const int erow = lane >> 4, epc = lane & 15;
    const bf16* Ze = Zb + (long)(wid * QBLK + erow) * AQW + 4 * epc; bf16* Ye = Yb + (long)(wid * QBLK + erow) * DM + 4 * epc;
    asm volatile("" : "+v"(Ze), "+v"(Ye) :: "memory");
#pragma unroll
    for (int ps = 0; ps < 2; ++ps) {
#pragma unroll
      for (int r = 0; r < 16; ++r)
#pragma unroll
        for (int dd = 0; dd < 2; ++dd) ep[crow(r, hi) * 64 + dd * 32 + r32] = o[2 * ps + dd][r] * rli[r];
      asm volatile("s_waitcnt lgkmcnt(0)" ::: "memory"); SBAR();
#pragma unroll
      for (int i = 0; i < 8; ++i) {
        const f32x4 v = *(const f32x4*)(ep + (erow + 4 * i) * 64 + 4 * epc);
        const u32x2 zz = ldg<u32x2>(Ze + (long)(4 * i) * AQW + 64 * ps);
        u32x2 w; w.x = cvtpk(v[0] * bflo(zz.x), v[1] * bfhi(zz.x)); w.y = cvtpk(v[2] * bflo(zz.y), v[3] * bfhi(zz.y));
        stg<u32x2>(Ye + (long)(4 * i) * DM + 64 * ps, w); }
      asm volatile("s_waitcnt lgkmcnt(0)" ::: "memory"); SBAR();
    } }
#else
#pragma unroll
  for (int r = 0; r < 16; ++r) { const int rr = (r & 3) + 8 * (r >> 2);
#pragma unroll
    for (int d0 = 0; d0 < 4; ++d0) { const float z = bf2f(ldg<bf16>(Zl + rr * AQW + d0 * 32)); stg<bf16>(Yl + rr * DM + d0 * 32, f2bf(o[d0][r] * rli[r] * z)); }
    if ((r & 3) == 3) { asm volatile("" ::: "memory"); SBAR(); } }
#endif
#undef SLOAD
#undef SWRITE
#undef SWAIT
#undef RESC
}
}

__device__ __forceinline__ int pperm(int d) { return d < 32 ? 2 * d : d < 64 ? 2 * (d - 32) + 1 : d < 96 ? 2 * (d - 32) : 2 * (d - 64) + 1; }
__device__ __forceinline__ int win_dest_row(int c) {
    if (c < SC_MO) return c;
    if (c < SC_MZ) { const int r = c - SC_MO; return DN_OZ + (r >> 7) * 256 + (r & 127); }
    if (c < SC_G)  { const int r = c - SC_MZ; return DN_OZ + (r >> 7) * 256 + 128 + (r & 127); }
    if (c < SC_AK) { const int r = c - SC_AQ; return DN_AQ + (r & ~127) + pperm(r & 127); }
    if (c < SC_AV) { const int r = c - SC_AK; return DN_AK + (r & ~127) + pperm(r & 127); }
    if (c < SC_AZ) return DN_AV + (c - SC_AV);
    return DN_AZ + (c - SC_AZ);
}
template <bool WIN> __device__ __forceinline__ void tr_item(const float* __restrict__ W, int ldw, bf16* __restrict__ WT, int k0, int c0, LAS float* scr, int lane) {
    const int kr = lane >> 4, cq = lane & 15;
    f32x4 v[16];
    const float* wp = W + (size_t)(k0 + kr) * ldw + c0 + 4 * cq;
#pragma unroll
    for (int i = 0; i < 16; ++i) v[i] = ldg<f32x4>(wp + (size_t)(4 * i) * ldw);
#pragma unroll
    for (int i = 0; i < 16; ++i) { LAS float* s = scr + (4 * i + kr) * 65 + 4 * cq; s[0] = v[i][0]; s[1] = v[i][1]; s[2] = v[i][2]; s[3] = v[i][3]; }
    LDS_WAIT();
    const int c = lane & 7;
#pragma unroll
    for (int j = 0; j < 8; ++j) {
        const int sl = (lane >> 3) + 8 * j; const LAS float* s = scr + (8 * c) * 65 + sl;
        u32x4 o; o.x = cvtpk(s[0 * 65], s[1 * 65]); o.y = cvtpk(s[2 * 65], s[3 * 65]); o.z = cvtpk(s[4 * 65], s[5 * 65]); o.w = cvtpk(s[6 * 65], s[7 * 65]);
        const int n = WIN ? win_dest_row(c0 + sl) : (c0 + sl);
        stg<u32x4>(WT + (size_t)n * DM + k0 + 8 * c, o);
    }
    LDS_WAIT();
}

struct Ptrs {
    const float *x, *c, *ctx, *c_ctx, *w_mod, *b_mod, *g_norm, *w_in, *b_gate, *g_mlstm, *g_q, *g_k, *w_out, *g_final;
    float* out; unsigned char* ws;
};

__device__ __forceinline__ void p0_prologue(const Ptrs& P, LAS unsigned char* lds, int gw, int NGW, int wave, int lane, const bool skip_wout, const bool skip_win1) {
    LAS float* scr = (LAS float*)(lds + wave * 16640);
    bf16* WinT = (bf16*)(P.ws + WS_WINT); bf16* WoutT = (bf16*)(P.ws + WS_WOUTT);
    constexpr int I_IN = 64 * 208, I_OUT = 64 * 64, I_L = I_IN + I_OUT;
    for (int it = gw; it < 2 * I_L; it += NGW) {
        const int l = it / I_L; int r = it % I_L;
        if (r < I_IN) { if (skip_win1 && l == 1) continue;
            const int kb = r / 208, cb = r % 208; const int c0 = cb < 128 ? 64 * cb : SC_AQ + 64 * (cb - 128);
            tr_item<true>(P.w_in + (size_t)l * DM * IN_COLS, IN_COLS, WinT + (size_t)l * NIN * DM, 64 * kb, c0, scr, lane); }
        else if (!skip_wout) { r -= I_IN; const int kb = r / 64, cb = r % 64;
            tr_item<false>(P.w_out + (size_t)l * DM * DM, DM, WoutT + (size_t)l * DM * DM, 64 * kb, 64 * cb, scr, lane); }
    }
    { bf16* WgT = (bf16*)(P.ws + WS_WGT);
      for (int idx = gw * 64 + lane; idx < 2 * 16 * DM; idx += NGW * 64) { const int l = idx >> 16, k = (idx >> 4) & (DM - 1), j = idx & 15;
          stg<bf16>(WgT + ((size_t)l * 16 + j) * DM + k, f2bf(ldg<float>(P.w_in + ((size_t)l * DM + k) * IN_COLS + SC_G + j))); } }
    if (gw == 0) { float* tab = (float*)(P.ws + WS_ROPE);
        for (int idx = lane; idx < 2048; idx += 64) { const int pos = idx >> 5, i = idx & 31; const float inv = powf(10000.0f, -(float)(2 * i) / 64.0f); const float a = (float)pos * inv;
            stg<float>(tab + idx, cosf(a)); stg<float>(tab + 2048 + idx, sinf(a)); } }
}

__device__ __forceinline__ void p0_wout_items(const Ptrs& P, LAS unsigned char* lds, int layer, int wv, int nwv, int wave, int lane) {
    LAS float* scr = (LAS float*)(lds + wave * 16640);
    bf16* WoutT = (bf16*)(P.ws + WS_WOUTT);
    for (int r = wv; r < 64 * 64; r += nwv) { const int kb = r / 64, cb = r % 64;
        tr_item<false>(P.w_out + (size_t)layer * DM * DM, DM, WoutT + (size_t)layer * DM * DM, 64 * kb, 64 * cb, scr, lane); }
}

__device__ __forceinline__ void p0_win1_items(const Ptrs& P, LAS unsigned char* lds, int gw, int NGW, int wave, int lane) {
    LAS float* scr = (LAS float*)(lds + wave * 16640);
    bf16* WinT = (bf16*)(P.ws + WS_WINT);
    for (int r = gw; r < 64 * 208; r += NGW) { const int kb = r / 208, cb = r % 208; const int c0 = cb < 128 ? 64 * cb : SC_AQ + 64 * (cb - 128);
        tr_item<true>(P.w_in + (size_t)DM * IN_COLS, IN_COLS, WinT + (size_t)NIN * DM, 64 * kb, c0, scr, lane); }
}

__device__ __forceinline__ void p0_mod(const Ptrs& P, int gw, int NGW, int lane) {
    { float* mod = (float*)(P.ws + WS_CTL + CTL_MOD_OFF);
      for (int it = gw; it < 2 * 64 * 48; it += NGW) {
          const int l = it / 3072, r = it % 3072, kb = r / 48, nb = r % 48, k0 = kb * 64, n0 = nb * 256 + 4 * lane;
          const float c0 = ldg<float>(P.c + k0 + lane), c1 = ldg<float>(P.c + DM + k0 + lane), c2 = ldg<float>(P.c_ctx + k0 + lane);
          const float s0 = c0 * (1.f / (1.f + __expf(-c0))), s1 = c1 * (1.f / (1.f + __expf(-c1))), s2 = c2 * (1.f / (1.f + __expf(-c2)));
          f32x4 a0 = {0.f, 0.f, 0.f, 0.f}, a1 = a0, a2 = a0;
          const float* wp = P.w_mod + ((size_t)l * DM + k0) * MODW + n0;
#pragma unroll 16
          for (int kk = 0; kk < 64; ++kk) { const f32x4 w4 = ldg<f32x4>(wp + (size_t)kk * MODW);
              a0 += w4 * shl_idx(s0, kk); a1 += w4 * shl_idx(s1, kk); a2 += w4 * shl_idx(s2, kk); }
          float* mp = mod + (size_t)l * 3 * MODW + n0;
#pragma unroll
          for (int e = 0; e < 4; ++e) { atomicAdd(mp + e, a0[e]); atomicAdd(mp + MODW + e, a1[e]); atomicAdd(mp + 2 * MODW + e, a2[e]); }
      } }
}

__device__ __forceinline__ void p1_norm(const Ptrs& P, int layer, int gw, int NGW, int lane_in, bool ksplit_prev, LAS unsigned char* lds, int tid) {
    bf16* XN = (bf16*)(P.ws + WS_XN); const float* XR1 = (const float*)(P.ws + WS_XR1);
    const float* mod = (const float*)(P.ws + WS_CTL + CTL_MOD_OFF) + (size_t)layer * 3 * MODW; const float* bm = P.b_mod + (size_t)layer * MODW; const float* gn = P.g_norm + (size_t)layer * DM;
    { LAS f32x4* T = (LAS f32x4*)lds;
#pragma unroll
      for (int q = 0; q < 6; ++q) { const int e = tid + 512 * q, m = e >> 10, k = 4 * (e & 1023); const float* mpm = mod + (size_t)m * MODW;
          const f32x4 g4 = ldg<f32x4>(gn + k), sh = ldg<f32x4>(mpm + k) + ldg<f32x4>(bm + k), sc = ldg<f32x4>(mpm + DM + k) + ldg<f32x4>(bm + DM + k);
          T[(2 * m) * 1024 + (e & 1023)] = g4 * (sc + 1.0f); T[(2 * m + 1) * 1024 + (e & 1023)] = sh; }
      __syncthreads(); }
    const bool special = layer == 1 && ksplit_prev && NGW > 1024;
    const bool heavy = special && gw < 512;
    const int it0 = !special ? gw : (heavy ? gw : gw - 512), stride = !special ? NGW : (heavy ? MROWS : NGW - 512), lim = !special ? MROWS : (heavy ? 512 : NBATCH * SEQ);
    for (int it = it0; it < lim; it += stride) {
        int lane = lane_in; asm volatile("" : "+v"(lane));
        const int R = !special ? it : (heavy ? (it >> 8) * TT + (it & 255) : (it >> 12) * TT + CTXL + (it & (SEQ - 1)));
        const int b = R / TT, tau = R % TT;
        const bool redu = layer == 1 && tau < CTXL && ksplit_prev;
        const float* src = (layer == 0 || redu) ? (tau < CTXL ? P.ctx + (size_t)(b * CTXL + tau) * DM : P.x + (size_t)(b * SEQ + tau - CTXL) * DM) : XR1 + (size_t)R * DM;
        const LAS f32x4* Tm = (const LAS f32x4*)lds + (tau < CTXL ? 2 : b) * 2048 + lane;
        f32x4 v[16]; float s = 0.f;
        if (MK_XR16 && !(layer == 0 || redu)) {
            const bf16* s16 = (const bf16*)XR1 + (size_t)R * DM + 4 * lane;
#pragma unroll
            for (int j = 0; j < 16; ++j) { const u32x2 w = ldg<u32x2>(s16 + 256 * j); v[j][0] = bflo(w.x); v[j][1] = bfhi(w.x); v[j][2] = bflo(w.y); v[j][3] = bfhi(w.y); }
        } else {
#pragma unroll
            for (int j = 0; j < 16; ++j) v[j] = ldg<f32x4>(src + 4 * lane + 256 * j);
        }
        if (redu) { const float* pp = (const float*)(P.ws + WS_PART) + (size_t)(b * CTXL + tau) * DM + 4 * lane;
            const float* g0 = (const float*)(P.ws + WS_CTL + CTL_MOD_OFF) + (size_t)2 * MODW + 2 * DM + 4 * lane; const float* gb0 = P.b_mod + 2 * DM + 4 * lane;
#pragma unroll
            for (int j = 0; j < 16; ++j) { f32x4 a = ldg<f32x4>(pp + 256 * j);
#pragma unroll
                for (int ks = 1; ks < 8; ++ks) a += ldg<f32x4>(pp + (size_t)ks * (NBATCH * CTXL) * DM + 256 * j);
                v[j] += (ldg<f32x4>(g0 + 256 * j) + ldg<f32x4>(gb0 + 256 * j)) * a;
                if (j & 1) { asm volatile("" ::: "memory"); __builtin_amdgcn_sched_barrier(0); } } }
#pragma unroll
        for (int j = 0; j < 16; ++j) s += (v[j][0] * v[j][0] + v[j][1] * v[j][1]) + (v[j][2] * v[j][2] + v[j][3] * v[j][3]);
        const float rstd = rsqrtf(wave_sum(s, lane) * (1.f / DM) + EPS);
        bf16* o = XN + (size_t)R * DM + 4 * lane;
#pragma unroll
        for (int j = 0; j < 16; ++j) {
            const f32x4 h = v[j] * rstd * Tm[64 * j] + Tm[1024 + 64 * j];
            u32x2 w; w.x = cvtpk(h[0], h[1]); w.y = cvtpk(h[2], h[3]); stg<u32x2>(o + 256 * j, w);
            if ((j & 3) == 3) { asm volatile("" ::: "memory"); __builtin_amdgcn_sched_barrier(0); } }
    }
}

__device__ __forceinline__ void p1_ctx_coop(const Ptrs& P, LAS unsigned char* lds, int bid, int wave, int lane) {
    const int cr = 2 * bid + (wave >> 2), q = wave & 3, b = cr >> 8, tau = cr & 255;
    const size_t ro = (size_t)(b * CTXL + tau) * DM + 1024 * q + 4 * lane;
    const float* src = P.ctx + ro; const float* pp = (const float*)(P.ws + WS_PART) + ro;
    const float* g0 = (const float*)(P.ws + WS_CTL + CTL_MOD_OFF) + (size_t)2 * MODW + 2 * DM + 1024 * q + 4 * lane; const float* gb0 = P.b_mod + 2 * DM + 1024 * q + 4 * lane;
    f32x4 v[4]; float s = 0.f;
#pragma unroll
    for (int j = 0; j < 4; ++j) { f32x4 a = ldg<f32x4>(pp + 256 * j);
#pragma unroll
        for (int ks = 1; ks < 8; ++ks) a += ldg<f32x4>(pp + (size_t)ks * (NBATCH * CTXL) * DM + 256 * j);
        v[j] = ldg<f32x4>(src + 256 * j) + (ldg<f32x4>(g0 + 256 * j) + ldg<f32x4>(gb0 + 256 * j)) * a;
        s += (v[j][0] * v[j][0] + v[j][1] * v[j][1]) + (v[j][2] * v[j][2] + v[j][3] * v[j][3]); }
    s = wave_sum(s, lane);
    LAS float* red = (LAS float*)lds;
    if (lane == 0) red[wave] = s;
    __syncthreads();
    const float rstd = rsqrtf(((red[wave & 4] + red[(wave & 4) + 1]) + (red[(wave & 4) + 2] + red[(wave & 4) + 3])) * (1.f / DM) + EPS);
    const float* mp = (const float*)(P.ws + WS_CTL + CTL_MOD_OFF) + (size_t)3 * MODW + (size_t)2 * MODW; const float* bm = P.b_mod + MODW; const float* gn = P.g_norm + DM;
    bf16* o = (bf16*)(P.ws + WS_XN) + (size_t)(b * TT + tau) * DM + 1024 * q + 4 * lane;
#pragma unroll
    for (int j = 0; j < 4; ++j) { const int k = 1024 * q + 4 * lane + 256 * j;
        const f32x4 g4 = ldg<f32x4>(gn + k), sh = ldg<f32x4>(mp + k) + ldg<f32x4>(bm + k), sc = ldg<f32x4>(mp + DM + k) + ldg<f32x4>(bm + DM + k);
        const f32x4 h = v[j] * rstd * g4 * (sc + 1.0f) + sh;
        u32x2 w; w.x = cvtpk(h[0], h[1]); w.y = cvtpk(h[2], h[3]); stg<u32x2>(o + 256 * j, w); }
    __syncthreads();
}

__device__ __forceinline__ void p2_gates(const Ptrs& P, int layer, LAS unsigned char* lds, int bid, int nblk, int wave, int lane, int tid) {
    const bf16* XN = (const bf16*)(P.ws + WS_XN); const bf16* WgT = (const bf16*)(P.ws + WS_WGT) + (size_t)layer * 16 * DM; float* G = (float*)(P.ws + WS_GATES);
    LAS float* red = (LAS float*)lds;
    const int i16 = lane & 15, g = lane >> 4;
    bf16x8 bfr[16];
#pragma unroll
    for (int s = 0; s < 16; ++s) bfr[s] = ldg<bf16x8>(WgT + (size_t)i16 * DM + wave * 512 + 32 * s + 8 * g);
    for (int p = bid; p < NPANEL; p += nblk) {
        f32x4 acc = {0.f, 0.f, 0.f, 0.f};
        const bf16* ap = XN + (size_t)(16 * p + i16) * DM + wave * 512 + 8 * g;
#pragma unroll
        for (int s = 0; s < 16; ++s) { const bf16x8 a = ldg<bf16x8>(ap + 32 * s); acc = mfma16(a, bfr[s], acc); }
#pragma unroll
        for (int r = 0; r < 4; ++r) red[wave * 256 + (4 * g + r) * 16 + i16] = acc[r];
        __syncthreads();
        if (tid < 256) { float s = 0.f;
#pragma unroll
            for (int w = 0; w < 8; ++w) s += red[w * 256 + tid];
            stg<float>(G + (size_t)(16 * p + (tid >> 4)) * 16 + (tid & 15), s + ldg<float>(P.b_gate + layer * 16 + (tid & 15))); }
        __syncthreads();
    }
}

__device__ __forceinline__ void p2b_qk_item(const Ptrs& P, int layer, int R, int pass, int lane) {
    const int tau = R % TT; const int li = lane & 15;
    const size_t eo = pass < 4 ? (size_t)R * AQW + pass * 512 + 8 * lane : (size_t)R * AKW + 8 * lane;
    const bf16* ptr = (const bf16*)(P.ws + (pass < 4 ? WS_AQ : WS_AK)) + eo; bf16* optr = (bf16*)(P.ws + (pass < 4 ? WS_AQN : WS_AKN)) + eo;
    const float* gg = (pass < 4 ? P.g_q : P.g_k) + (size_t)layer * HD;
    const u32x4 raw = ldg<u32x4>(ptr);
    float xv[8];
#pragma unroll
    for (int i = 0; i < 4; ++i) { xv[2 * i] = bflo(raw[i]); xv[2 * i + 1] = bfhi(raw[i]); }
    float ss = 0.f;
#pragma unroll
    for (int e = 0; e < 8; ++e) ss += xv[e] * xv[e];
    ss += shl_xor(ss, 1, lane); ss += shl_xor(ss, 2, lane); ss += shl_xor(ss, 4, lane); ss += shl_xor(ss, 8, lane);
    const float rstd = rsqrtf(ss * (1.f / HD) + EPS);
    const int base1 = li < 8 ? 4 * li : 4 * li + 32;
    const f32x4 g1 = ldg<f32x4>(gg + base1), g2 = ldg<f32x4>(gg + base1 + 32);
    float x1[4], x2[4];
#pragma unroll
    for (int q = 0; q < 4; ++q) { x1[q] = xv[2 * q] * rstd * g1[q]; x2[q] = xv[2 * q + 1] * rstd * g2[q]; }
    if (tau >= CTXL) {
        const int t = tau - CTXL; const int pos = li < 8 ? (t >> 6) : (t & 63);
        const float* tab = (const float*)(P.ws + WS_ROPE);
        const f32x4 cs = ldg<f32x4>(tab + pos * 32 + 4 * (li & 7)), sn = ldg<f32x4>(tab + 2048 + pos * 32 + 4 * (li & 7));
#pragma unroll
        for (int q = 0; q < 4; ++q) { const float a = x1[q], b = x2[q]; x1[q] = a * cs[q] - b * sn[q]; x2[q] = a * sn[q] + b * cs[q]; }
    }
    u32x4 o; o.x = cvtpk(x1[0], x2[0]); o.y = cvtpk(x1[1], x2[1]); o.z = cvtpk(x1[2], x2[2]); o.w = cvtpk(x1[3], x2[3]);
    stg<u32x4>(optr, o);
}
__device__ __forceinline__ void p2b_tr_item(const bf16* __restrict__ src, int ld, bf16* __restrict__ dstb, int NRT, int r0, int step0, LAS bf16* scr, int lane) {
    const int rr = lane >> 3, cg = lane & 7;
    u32x4 v[8];
#pragma unroll
    for (int i = 0; i < 8; ++i) v[i] = ldg<u32x4>(src + (size_t)(8 * i + rr) * ld + 8 * cg);
#pragma unroll
    for (int i = 0; i < 8; ++i) { const int row = 8 * i + rr;
#pragma unroll
        for (int e = 0; e < 4; ++e) { scr[(8 * cg + 2 * e) * 72 + row] = (bf16)(v[i][e] & 0xffffu); scr[(8 * cg + 2 * e + 1) * 72 + row] = (bf16)(v[i][e] >> 16); } }
    LDS_WAIT();
    { const int i16 = lane & 15, g = lane >> 4;
#pragma unroll
      for (int f = 0; f < 8; ++f) { const int rtl = f >> 1, stl = f & 1;
          const u32x4 o = *(const LAS u32x4*)(scr + (16 * rtl + i16) * 72 + 32 * stl + 8 * g);
          stg<u32x4>(dstb + ((size_t)(step0 + stl) * NRT + (r0 >> 4) + rtl) * 512 + lane * 8, o); } }
    LDS_WAIT();
}
__device__ __forceinline__ int chunk_at(int dir, int step) { return dir == 0 ? step : (step == 0 ? 1 : (step == 1 ? 0 : 35 - step)); }
__device__ __forceinline__ void p2b_scan_item(const Ptrs& P, int seq, int j, int lane) {
    const int dir = seq >> 3, b = (seq >> 2) & 1, h = seq & 3;
    const float* G = (const float*)(P.ws + WS_GATES);
    float* U = (float*)(P.ws + WS_SCAN) + (size_t)seq * TT; float* BCp = U + NSEQ * TT; float* CMp = BCp + NSEQ * TT;
    float* BT = (float*)(P.ws + WS_ACH) + seq * NCH; float* UM = BT + NSEQ * NCH;
    const int p0 = 2 * lane, p1 = 2 * lane + 1;
    const int t0 = dir == 0 ? p0 : 127 - p0, t1 = dir == 0 ? p1 : 127 - p1;
    const size_t R0 = (size_t)b * TT + CHK * j;
    const float i0 = ldg<float>(G + (R0 + t0) * 16 + dir * 8 + h), f0 = ldg<float>(G + (R0 + t0) * 16 + dir * 8 + 4 + h);
    const float i1 = ldg<float>(G + (R0 + t1) * 16 + dir * 8 + h), f1 = ldg<float>(G + (R0 + t1) * 16 + dir * 8 + 4 + h);
    const float lf0 = fminf(f0, 0.f) - log1pf(expf(-fabsf(f0))), lf1 = fminf(f1, 0.f) - log1pf(expf(-fabsf(f1)));
    float tot = lf0 + lf1, inc = tot;
#pragma unroll
    for (int o = 1; o < 64; o <<= 1) { const float y = shl_up(inc, o, lane); if (lane >= o) inc += y; }
    const float ex = inc - tot, b0 = ex + lf0, b1 = ex + tot;
    const float u0 = i0 - b0, u1 = i1 - b1;
    float cm = fmaxf(u0, u1), cinc = cm;
#pragma unroll
    for (int o = 1; o < 64; o <<= 1) { const float y = shl_up(cinc, o, lane); if (lane >= o) cinc = fmaxf(cinc, y); }
    float cex = shl_up(cinc, 1, lane); if (lane == 0) cex = -3.0e38f;
    const int o0 = CHK * j + t0, o1 = CHK * j + t1;
    stg<float>(U + o0, u0); stg<float>(U + o1, u1); stg<float>(BCp + o0, b0); stg<float>(BCp + o1, b1);
    stg<float>(CMp + o0, fmaxf(cex, u0)); stg<float>(CMp + o1, cinc);
    if (lane == 63) { stg<float>(BT + j, b1); stg<float>(UM + j, cinc); }
}

__device__ __forceinline__ bf16x8 scale_frag8(bf16x8 f, const f32x4 w0, const f32x4 w1) {
    u32x4 u = __builtin_bit_cast(u32x4, f);
    u.x = cvtpk(bflo(u.x) * w0[0], bfhi(u.x) * w0[1]); u.y = cvtpk(bflo(u.y) * w0[2], bfhi(u.y) * w0[3]);
    u.z = cvtpk(bflo(u.z) * w1[0], bfhi(u.z) * w1[1]); u.w = cvtpk(bflo(u.w) * w1[2], bfhi(u.w) * w1[3]);
    return __builtin_bit_cast(bf16x8, u);
}

__device__ __forceinline__ void p3_chain_block(const Ptrs& P, int cb, int wave, int lane, LAS unsigned char* lds) {
    const int seq = cb >> 1, vh = cb & 1, kt = wave & 3, vq = wave >> 2;
    const int dir = seq >> 3, b = (seq >> 2) & 1, h = seq & 3;
    const int i16 = lane & 15, g = lane >> 4;
    const unsigned lane16 = (unsigned)lane * 16u;
    const char* dsrc = wave < 4 ? (const char*)(P.ws + WS_KT) + ((size_t)(b * MH + h) * (4 * NCH * 16) + 4 * wave) * 1024
                                : (const char*)(P.ws + WS_VT) + ((size_t)(b * MH + h) * (4 * NCH * 32) + 16 * vh + 4 * (wave - 4)) * 1024;
    const unsigned dstep = wave < 4 ? 16u * 1024u : 32u * 1024u;
    LAS unsigned char* ring = lds;
    LAS float* wl = (LAS float*)(lds + 131072) + wave * 128;
    const char* UB = (const char*)((const float*)(P.ws + WS_SCAN) + (size_t)seq * TT);
    LAS unsigned char* ual = lds + 135168;
    float mc_l = 0.f, mu_l = 0.f;
    { float* BT = (float*)(P.ws + WS_ACH) + seq * NCH; float* UM = BT + NSEQ * NCH; float* MC = UM + NSEQ * NCH; float* MU = MC + NSEQ * NCH;
      const int jl = chunk_at(dir, lane < NCH ? lane : 0);
      const float btv = ldg<float>(BT + jl), umv = ldg<float>(UM + jl);
      float m = 0.f;
      for (int step = 0; step < NCH; ++step) { const float bt = shl_idx(btv, step), um = shl_idx(umv, step), mu = fmaxf(m, um); if (lane == step) { mc_l = m; mu_l = mu; } m = bt + mu; }
      if (vh == 0 && wave == 0 && lane < NCH) { stg<float>(MC + jl, mc_l); stg<float>(MU + jl, mu_l); } }
    float mu_cur = 0.f, ac = 1.f;
    char* CSTu = (char*)((bf16*)(P.ws + WS_CST) + ((size_t)seq * NCH) * MDV * MDK) + ((size_t)(16 * vh + 8 * vq) * 8 + 2 * kt) * 1024;
    char* NSTu = (char*)((float*)(P.ws + WS_NST) + (size_t)seq * NCH * MDK + 64 * kt);
    f32x4 C[4][8];
#pragma unroll
    for (int a = 0; a < 4; ++a)
#pragma unroll
        for (int bb = 0; bb < 8; ++bb) C[a][bb] = (f32x4){0.f, 0.f, 0.f, 0.f};
    f32x4 Nacc[4];
#pragma unroll
    for (int a = 0; a < 4; ++a) Nacc[a] = (f32x4){0.f, 0.f, 0.f, 0.f};
#define CHB_DMA(sub) do { const int st_ = 4 * chunk_at(dir, (sub) >> 2) + ((sub) & 3); const char* sp_ = dsrc + (size_t)st_ * dstep; asm volatile("" : "+s"(sp_)); \
        LAS unsigned char* dp_ = ring + (((sub) & 3) * 32 + 4 * wave) * 1024; \
        _Pragma("unroll") for (int q = 0; q < 4; ++q) __builtin_amdgcn_global_load_lds((const unsigned*)(sp_ + lane16 + q * 1024), (LAS unsigned*)(dp_ + q * 1024), 16, 0, 0); } while (0)
#define CHB_STEP(s, PP) do { \
        if ((PP) == 0) asm volatile("s_waitcnt vmcnt(8) lgkmcnt(0)" ::: "memory"); else asm volatile("s_waitcnt vmcnt(29) lgkmcnt(0)" ::: "memory"); \
        __builtin_amdgcn_s_barrier(); asm volatile("" ::: "memory"); \
        CHB_DMA((s) + 3); \
        asm volatile("" ::: "memory"); \
        if ((PP) == 0) { \
            int ln_ = lane; asm volatile("" : "+v"(ln_));            \
            const unsigned cstl_ = (unsigned)((ln_ & 15) + 16 * (2 * ((ln_ >> 4) & 1) + (ln_ >> 5))) * 16u, nstl_ = (unsigned)(ln_ >> 4) * 16u, l8_ = (unsigned)ln_ * 8u; \
            { const float mc = shl_idx(mc_l, (s) >> 2); mu_cur = shl_idx(mu_l, (s) >> 2); ac = __expf(mc - mu_cur); } \
            { const f32x2 un = *(const LAS f32x2*)(ual + (((s) >> 2) & 1) * 1024 + l8_); f32x2 w2; w2.x = __expf(un.x - mu_cur); w2.y = __expf(un.y - mu_cur); *(LAS f32x2*)(wl + 2 * ln_) = w2; } \
            asm volatile("s_waitcnt lgkmcnt(0)" ::: "memory"); \
            { const int cn_ = ((s) >> 2) + 1 < NCH ? ((s) >> 2) + 1 : NCH - 1; const char* up_ = UB + (size_t)(CHK * chunk_at(dir, cn_)) * 4; asm volatile("" : "+s"(up_)); \
              __builtin_amdgcn_global_load_lds((const unsigned*)(up_ + lane16), (LAS unsigned*)(ual + ((((s) >> 2) + 1) & 1) * 1024), 16, 0, 0); }     \
            const int jc_ = chunk_at(dir, (s) >> 2); \
            char* cst = CSTu + (size_t)jc_ * MDV * MDK * 2; char* nst = NSTu + (size_t)jc_ * MDK * 4; asm volatile("" : "+s"(cst), "+s"(nst)); \
              \
            _Pragma("unroll") for (int m = 0; m < 2; ++m) _Pragma("unroll") for (int bb = 0; bb < 8; ++bb) { \
                    const unsigned x0 = cvtpk(C[2 * m][bb][0], C[2 * m][bb][1]), x1 = cvtpk(C[2 * m][bb][2], C[2 * m][bb][3]), y0 = cvtpk(C[2 * m + 1][bb][0], C[2 * m + 1][bb][1]), y1 = cvtpk(C[2 * m + 1][bb][2], C[2 * m + 1][bb][3]); \
                    const auto s0_ = __builtin_amdgcn_permlane16_swap(x0, y0, false, false); const auto s1_ = __builtin_amdgcn_permlane16_swap(x1, y1, false, false); \
                    const u32x4 o = {s0_[0], s1_[0], s0_[1], s1_[1]}; \
                    stg<u32x4>(cst + cstl_ + (bb * 8 + m) * 1024, o); \
                    C[2 * m][bb] = C[2 * m][bb] * ac; C[2 * m + 1][bb] = C[2 * m + 1][bb] * ac; \
                    if (bb == 7) { asm volatile("" ::: "memory"); __builtin_amdgcn_sched_barrier(0); } } \
            _Pragma("unroll") for (int a = 0; a < 4; ++a) { stg<f32x4>(nst + nstl_ + 64 * a, Nacc[a]); Nacc[a] = Nacc[a] * ac; }     \
            asm volatile("" ::: "memory"); \
        } \
        { const LAS unsigned char* sl_ = ring + ((s) & 3) * 32768 + lane16; \
          const f32x4 W0 = *(const LAS f32x4*)(wl + 32 * (PP) + 8 * g), W1 = *(const LAS f32x4*)(wl + 32 * (PP) + 8 * g + 4); \
          bf16x8 kf[4]; \
          _Pragma("unroll") for (int a = 0; a < 4; ++a) kf[a] = scale_frag8(*(const LAS bf16x8*)(sl_ + (4 * kt + a) * 1024), W0, W1); \
          _Pragma("unroll") for (int bb = 0; bb < 8; ++bb) { const bf16x8 vf = *(const LAS bf16x8*)(sl_ + (16 + 8 * vq + bb) * 1024); \
              _Pragma("unroll") for (int a = 0; a < 4; ++a) C[a][bb] = mfma16(kf[a], vf, C[a][bb]);        \
              if ((bb & 3) == 3) { asm volatile("" ::: "memory"); __builtin_amdgcn_sched_barrier(0); } } \
          { unsigned o1_ = 0x3F803F80u; asm volatile("" : "+v"(o1_)); const u32x4 ou_ = {o1_, o1_, o1_, o1_}; const bf16x8 ones = __builtin_bit_cast(bf16x8, ou_);     \
            _Pragma("unroll") for (int a = 0; a < 4; ++a) Nacc[a] = mfma16(kf[a], ones, Nacc[a]); } } \
        asm volatile("" ::: "memory"); __builtin_amdgcn_sched_barrier(0); } while (0)
    __builtin_amdgcn_global_load_lds((const unsigned*)(UB + (size_t)(CHK * chunk_at(dir, 0)) * 4 + lane16), (LAS unsigned*)ual, 16, 0, 0);
    asm volatile("s_waitcnt vmcnt(0)" ::: "memory");
    CHB_DMA(0); CHB_DMA(1); CHB_DMA(2);
#pragma clang loop unroll(disable)
    for (int sub = 0; sub < 132; sub += 12) {
        asm volatile("" : "+s"(sub));
        CHB_STEP(sub + 0, 0);
        CHB_STEP(sub + 1, 1);
        CHB_STEP(sub + 2, 2);
        CHB_STEP(sub + 3, 3);
        CHB_STEP(sub + 4, 0);
        CHB_STEP(sub + 5, 1);
        CHB_STEP(sub + 6, 2);
        CHB_STEP(sub + 7, 3);
        CHB_STEP(sub + 8, 0);
        CHB_STEP(sub + 9, 1);
        CHB_STEP(sub + 10, 2);
        CHB_STEP(sub + 11, 3);
    }
    CHB_STEP(132 + 0, 0);
    CHB_STEP(132 + 1, 1);
    CHB_STEP(132 + 2, 2);
    CHB_STEP(132 + 3, 3);
#undef CHB_STEP
#undef CHB_DMA
    asm volatile("s_waitcnt vmcnt(0) lgkmcnt(0)" ::: "memory");
}

template <int KIND> __device__ __forceinline__ void p4_tile_load(u32x4 (&st)[4], const bf16* src, int ld, int tid) {
#pragma unroll
    for (int q = 0; q < 4; ++q) { const int c = tid + 512 * q;
        if (KIND == 0) { const int row = c >> 5, cc = c & 31; st[q] = ldg<u32x4>(src + (size_t)row * ld + 8 * cc); }
        else { const int f = c >> 6, l = c & 63; st[q] = ldg<u32x4>(src + (size_t)(f >> 3) * ld + ((f & 7) * 64 + l) * 8); } }
}
template <int KIND, bool KSWZ_> __device__ __forceinline__ void p4_tile_write(const u32x4 (&st)[4], LAS unsigned char* buf, int tid) {
#pragma unroll
    for (int q = 0; q < 4; ++q) { const int c = tid + 512 * q;
        if (KIND == 0) { const int row = c >> 5, cc = c & 31; const int f = KSWZ_ ? ((row & 3) | (((row >> 3) & 3) << 2)) : (row & 15);
            *(LAS u32x4*)(buf + row * 512 + ((cc ^ f) << 4)) = st[q]; }
        else if (KIND == 1) *(LAS u32x4*)(buf + c * 16) = st[q];
        else { const int f = c >> 6, l = c & 63, row = 16 * (f >> 3) + (l & 15), cc = 4 * (f & 7) + (l >> 4);
            *(LAS u32x4*)(buf + row * 512 + ((cc ^ (row & 15)) << 4)) = st[q]; } }
}
__device__ __forceinline__ void p4_m2_unit(const Ptrs& P, int layer, int b, int h, int j, int wave, int tid_in, LAS unsigned char* lds, const bool skip_epi = false) {
    int tid = tid_in; asm volatile("" : "+v"(tid));
    const int lane = tid & 63, i16 = lane & 15, g = lane >> 4;
    const int R0 = b * TT + CHK * j, t_loc = 16 * wave + i16;
    const bf16* mq = (const bf16*)(P.ws + WS_MQ); const bf16* mk = (const bf16*)(P.ws + WS_MK); const bf16* vT = (const bf16*)(P.ws + WS_VT);
    const bf16* CST = (const bf16*)(P.ws + WS_CST); const float* NST = (const float*)(P.ws + WS_NST);
    const float* U = (const float*)(P.ws + WS_SCAN); const float* BCp = U + NSEQ * TT; const float* CMp = BCp + NSEQ * TT; const float* MCp = (const float*)(P.ws + WS_ACH) + 2 * NSEQ * NCH;
    const int seqf = b * 4 + h, seqb = (2 + b) * 4 + h;
    const bf16* ksrc = mk + (size_t)R0 * MQW + h * MDK;
    const bf16* vsrc = vT + (size_t)(b * MH + h) * (4 * NCH * 32 * 512) + (size_t)(4 * j) * (32 * 512);
    constexpr int VSTEP = 32 * 512;
    const bf16* cfsrc = CST + ((size_t)seqf * NCH + j) * MDV * MDK; const bf16* cbsrc = CST + ((size_t)seqb * NCH + j) * MDV * MDK;
    const bf16* qp = mq + (size_t)(R0 + t_loc) * MQW + h * MDK + 8 * g;
    bf16x8 qf[8];
    const unsigned lane16 = (unsigned)lane * 16u;
    constexpr int M2R = MK_M2RING;
#define M2_DST(i, jj) (lds + ((i) % M2R) * 32768 + wave * 4096 + (jj) * 1024)
#define M2_DMA_K(i, kt) do { _Pragma("unroll") for (int jj = 0; jj < 4; ++jj) { const int row = wave * 8 + jj * 2 + (lane >> 5), slot = lane & 31, cc = slot ^ ((row & 3) | (((row >> 3) & 3) << 2)); \
        __builtin_amdgcn_global_load_lds((const unsigned*)(ksrc + (size_t)(64 * (kt) + row) * MQW + cc * 8), (LAS unsigned*)M2_DST(i, jj), 16, 0, 0); } } while (0)
#define M2_DMA_V(i, vt) do { _Pragma("unroll") for (int jj = 0; jj < 4; ++jj) { const int f = wave * 4 + jj; \
        __builtin_amdgcn_global_load_lds((const unsigned*)((const char*)(vsrc + (size_t)(8 * (vt)) * 512 + (size_t)(f >> 3) * VSTEP + (f & 7) * 512) + lane16), (LAS unsigned*)M2_DST(i, jj), 16, 0, 0); } } while (0)
#define M2_DMA_C(i, base, ct) do { _Pragma("unroll") for (int jj = 0; jj < 4; ++jj) \
        __builtin_amdgcn_global_load_lds((const unsigned*)((const char*)((base) + (size_t)(ct) * 16384 + (wave * 4 + jj) * 512) + lane16), (LAS unsigned*)M2_DST(i, jj), 16, 0, 0); } while (0)
#define M2_DMA(i) do { if ((i) < 2) M2_DMA_K(i, i); else if ((i) < 6) M2_DMA_V(i, (i) - 2); else if ((i) < 14) M2_DMA_C(i, cfsrc, (i) - 6); else if ((i) < 22) M2_DMA_C(i, cbsrc, (i) - 14); } while (0)
#define M2_SYNC(K) do { asm volatile("s_waitcnt vmcnt(" #K ") lgkmcnt(0)" ::: "memory"); __builtin_amdgcn_s_barrier(); asm volatile("" ::: "memory"); } while (0)
#pragma unroll
    for (int ks = 0; ks < 8; ++ks) qf[ks] = ldg<bf16x8>(qp + 32 * ks);
    asm volatile("" ::: "memory");
    M2_DMA(0); M2_DMA(1); if (M2R == 4) M2_DMA(2);
    f32x4 S[8];
#pragma unroll
    for (int T = 0; T < 8; ++T) S[T] = (f32x4){0.f, 0.f, 0.f, 0.f};
#pragma unroll
    for (int kt = 0; kt < 2; ++kt) {
        if (M2R == 4) M2_SYNC(8); else M2_SYNC(4);
        M2_DMA(kt + M2R - 1);
        asm volatile("" ::: "memory");
        const LAS unsigned char* bufr = lds + (kt % M2R) * 32768;
        bf16x8 kfr[2][4];
#define M2_KRD(ks, tl) (*(const LAS bf16x8*)(bufr + (32 * ((tl) >> 1) + 8 * (i16 >> 2) + 4 * ((tl) & 1) + (i16 & 3)) * 512 + (((4 * (ks) + g) ^ i16) << 4)))
#pragma unroll
        for (int tl = 0; tl < 4; ++tl) kfr[0][tl] = M2_KRD(0, tl);
#pragma unroll
        for (int ks = 0; ks < 8; ++ks) {
            if (ks < 7) {
#pragma unroll
                for (int tl = 0; tl < 4; ++tl) kfr[(ks + 1) & 1][tl] = M2_KRD(ks + 1, tl); }
            __builtin_amdgcn_sched_barrier(0);
#pragma unroll
            for (int tl = 0; tl < 4; ++tl) S[4 * kt + tl] = mfma16(kfr[ks & 1][tl], qf[ks], S[4 * kt + tl]);
            __builtin_amdgcn_sched_barrier(0);
        }
#undef M2_KRD
    }
    bf16x8 pf[2][4]; float cCr[2][4];
#pragma unroll
    for (int dir = 0; dir < 2; ++dir) {
        const int seq = (dir * 2 + b) * 4 + h;
        const size_t so = (size_t)seq * TT + CHK * j;
        const float mc = ldg<float>(MCp + seq * NCH + j), Mt = fmaxf(mc, ldg<float>(CMp + so + t_loc)), wst = __expf(mc - Mt), eneg = __expf(-(ldg<float>(BCp + so + t_loc) + Mt));
        f32x4 sdv[8]; float rs = 0.f;
#pragma unroll
        for (int T = 0; T < 8; ++T) { const f32x4 u4 = ldg<f32x4>(U + so + 32 * (T >> 1) + 8 * g + 4 * (T & 1));
#pragma unroll
            for (int r = 0; r < 4; ++r) { const int s = 32 * (T >> 1) + 8 * g + 4 * (T & 1) + r; const bool ok = dir == 0 ? (s <= t_loc) : (s >= t_loc);
                sdv[T][r] = ok ? S[T][r] * __expf(u4[r] - Mt) : 0.f; rs += sdv[T][r]; } }
        rs += shl_xor(rs, 16, lane); rs += shl_xor(rs, 32, lane);
        float qn = 0.f;
        { const float* np = NST + ((size_t)seq * NCH + j) * MDK + 8 * g;
#pragma unroll
          for (int ks = 0; ks < 8; ++ks) { const f32x4 n0 = ldg<f32x4>(np + 32 * ks), n1 = ldg<f32x4>(np + 32 * ks + 4); const u32x4 qu = __builtin_bit_cast(u32x4, qf[ks]);
              qn += bflo(qu.x) * n0[0] + bfhi(qu.x) * n0[1] + bflo(qu.y) * n0[2] + bfhi(qu.y) * n0[3] + bflo(qu.z) * n1[0] + bfhi(qu.z) * n1[1] + bflo(qu.w) * n1[2] + bfhi(qu.w) * n1[3]; } }
        qn += shl_xor(qn, 16, lane); qn += shl_xor(qn, 32, lane);
        const float den = wst * qn + rs, dn = fmaxf(fabsf(den), eneg), cS = 1.0f / dn, cC = wst * cS;
#pragma unroll
        for (int p = 0; p < 4; ++p) {
            u32x4 u; u.x = cvtpk(sdv[2 * p][0] * cS, sdv[2 * p][1] * cS); u.y = cvtpk(sdv[2 * p][2] * cS, sdv[2 * p][3] * cS);
            u.z = cvtpk(sdv[2 * p + 1][0] * cS, sdv[2 * p + 1][1] * cS); u.w = cvtpk(sdv[2 * p + 1][2] * cS, sdv[2 * p + 1][3] * cS); pf[dir][p] = __builtin_bit_cast(bf16x8, u);
        }
#pragma unroll
        for (int r = 0; r < 4; ++r) cCr[dir][r] = shl_idx(cC, 4 * g + r);
    }
    f32x4 H[32];
#pragma unroll
    for (int vt = 0; vt < 4; ++vt) {
        if (M2R == 4) M2_SYNC(8); else M2_SYNC(4);
        M2_DMA(vt + 2 + M2R - 1);
        asm volatile("" ::: "memory");
        const LAS unsigned char* bufr = lds + ((vt + 2) % M2R) * 32768;
#pragma unroll
        for (int n = 0; n < 8; ++n) H[8 * vt + n] = (f32x4){0.f, 0.f, 0.f, 0.f};
        bf16x8 vfr[2][4];
#define M2_VRD(bb, n) (*(const LAS bf16x8*)(bufr + ((8 * ((bb) >> 1) + 4 * ((bb) & 1) + (n)) * 64 + lane) * 16))
#pragma unroll
        for (int n = 0; n < 4; ++n) vfr[0][n] = M2_VRD(0, n);
#pragma unroll
        for (int bb = 0; bb < 8; ++bb) {
            if (bb < 7) {
#pragma unroll
                for (int n = 0; n < 4; ++n) vfr[(bb + 1) & 1][n] = M2_VRD(bb + 1, n); }
            __builtin_amdgcn_sched_barrier(0);
#pragma unroll
            for (int n = 0; n < 4; ++n) H[8 * vt + 4 * (bb & 1) + n] = mfma16(pf[0][bb >> 1], vfr[bb & 1][n], H[8 * vt + 4 * (bb & 1) + n]);
#pragma unroll
            for (int n = 0; n < 4; ++n) H[8 * vt + 4 * (bb & 1) + n] = mfma16(pf[1][bb >> 1], vfr[bb & 1][n], H[8 * vt + 4 * (bb & 1) + n]);
            __builtin_amdgcn_sched_barrier(0);
        }
#undef M2_VRD
    }
    bf16x8 qg[8];
    { unsigned zq2 = 0u; asm volatile("" : "+s"(zq2)); const int lq = (int)__builtin_amdgcn_mbcnt_hi(~0u, __builtin_amdgcn_mbcnt_lo(~0u, zq2));
      const bf16* qp2 = mq + (size_t)(R0 + 16 * wave + (lq & 15)) * MQW + h * MDK + 8 * (lq >> 4); asm volatile("" : "+v"(qp2) :: "memory");
#pragma unroll
      for (int ks = 0; ks < 8; ++ks) qg[ks] = ldg<bf16x8>(qp2 + 32 * ks); }
#pragma unroll
    for (int ct = 0; ct < 16; ++ct) {
        if (M2R == 4) { if (ct < 14) M2_SYNC(8); else if (ct == 14) M2_SYNC(4); else M2_SYNC(0); }
        else { if (ct < 15) M2_SYNC(4); else M2_SYNC(0); }
        M2_DMA(ct + 6 + M2R - 1);
        asm volatile("" ::: "memory");
        const LAS unsigned char* bufr = lds + ((ct + 6) % M2R) * 32768;
#define M2_CRD(ks, n) (*(const LAS bf16x8*)(bufr + ((8 * (n) + (ks)) * 64 + lane) * 16))
#pragma unroll
        for (int nh = 0; nh < 2; ++nh) {
            f32x4 tf[2]; bf16x8 cfr[2][2];
#pragma unroll
            for (int n = 0; n < 2; ++n) { tf[n] = (f32x4){0.f, 0.f, 0.f, 0.f}; cfr[0][n] = M2_CRD(0, 2 * nh + n); }
#pragma unroll
            for (int ks = 0; ks < 8; ++ks) {
                if (ks < 7) {
#pragma unroll
                    for (int n = 0; n < 2; ++n) cfr[(ks + 1) & 1][n] = M2_CRD(ks + 1, 2 * nh + n); }
                __builtin_amdgcn_sched_barrier(0);
#pragma unroll
                for (int n = 0; n < 2; ++n) tf[n] = mfma16(qg[ks], cfr[ks & 1][n], tf[n]);
                __builtin_amdgcn_sched_barrier(0);
            }
#pragma unroll
            for (int n = 0; n < 2; ++n) {
#pragma unroll
                for (int r = 0; r < 4; ++r) H[4 * (ct & 7) + 2 * nh + n][r] += cCr[ct >> 3][r] * tf[n][r];
                asm volatile("" : "+v"(H[4 * (ct & 7) + 2 * nh + n])); }
        }
#undef M2_CRD
    }
    asm volatile("s_waitcnt lgkmcnt(0)" ::: "memory"); __builtin_amdgcn_s_barrier(); asm volatile("" ::: "memory");
#undef M2_SYNC
#undef M2_DMA
#undef M2_DMA_C
#undef M2_DMA_V
#undef M2_DMA_K
#undef M2_DST
    unsigned zf = 0u; asm volatile("" : "+s"(zf)); int lnf = (int)__builtin_amdgcn_mbcnt_hi(~0u, __builtin_amdgcn_mbcnt_lo(~0u, zf)); asm volatile("" : "+v"(lnf));
    const int i16f = lnf & 15, gf = lnf >> 4;
    float ss[4] = {0.f, 0.f, 0.f, 0.f};
#pragma unroll
    for (int nt = 0; nt < 32; ++nt)
#pragma unroll
        for (int r = 0; r < 4; ++r) ss[r] += H[nt][r] * H[nt][r];
    float rstd[4];
#pragma unroll
    for (int r = 0; r < 4; ++r) { float s_ = ss[r]; s_ += shl_xor(s_, 1, lnf); s_ += shl_xor(s_, 2, lnf); s_ += shl_xor(s_, 4, lnf); s_ += shl_xor(s_, 8, lnf); rstd[r] = rsqrtf(s_ * (1.f / MDV) + EPS); }
    const int rowb = R0 + 16 * wave + 4 * gf, colb = h * MDV + i16f;
    const float* gm = P.g_mlstm + (size_t)layer * MVW + colb;
    const bf16* mg = (const bf16*)(P.ws + WS_MG) + (size_t)rowb * MVW + colb;
    bf16* Y = (bf16*)(P.ws + WS_Y) + (size_t)rowb * DM + colb;
    asm volatile("" : "+v"(gm), "+v"(mg), "+v"(Y));
#if MK_PER_PHASE
    if (skip_epi) return;
#endif
#if MK_EPILDS
    (void)mg; (void)Y;
    { LAS float* ep = (LAS float*)lds + wave * 2176;
      const int erow = lnf >> 5, epc = lnf & 31;
      const bf16* mge = (const bf16*)(P.ws + WS_MG) + (size_t)(R0 + 16 * wave + erow) * MVW + h * MDV + 4 * epc;
      bf16* Ye = (bf16*)(P.ws + WS_Y) + (size_t)(R0 + 16 * wave + erow) * DM + h * MDV + 4 * epc;
      asm volatile("" : "+v"(mge), "+v"(Ye) :: "memory");
#pragma unroll
      for (int ps = 0; ps < 4; ++ps) {
#pragma unroll
          for (int n8 = 0; n8 < 8; ++n8) { const float gmv = ldg<float>(gm + 16 * (8 * ps + n8));
#pragma unroll
              for (int r = 0; r < 4; ++r) ep[(4 * gf + r) * 132 + 16 * n8 + i16f] = H[8 * ps + n8][r] * rstd[r] * gmv; }
          asm volatile("s_waitcnt lgkmcnt(0)" ::: "memory"); __builtin_amdgcn_sched_barrier(0);
#pragma unroll
          for (int i = 0; i < 8; ++i) {
              const f32x4 v = *(const LAS f32x4*)(ep + (erow + 2 * i) * 132 + 4 * epc);
              const u32x2 gg = ldg<u32x2>(mge + (size_t)(2 * i) * MVW + 128 * ps);
              u32x2 w; w.x = cvtpk(v[0] * bflo(gg.x), v[1] * bfhi(gg.x)); w.y = cvtpk(v[2] * bflo(gg.y), v[3] * bfhi(gg.y));
              stg<u32x2>(Ye + (size_t)(2 * i) * DM + 128 * ps, w); }
          asm volatile("s_waitcnt lgkmcnt(0)" ::: "memory"); __builtin_amdgcn_sched_barrier(0);
      } }
#else
#pragma unroll
    for (int nt = 0; nt < 32; ++nt) { const float gmv = ldg<float>(gm + 16 * nt);
#pragma unroll
        for (int r = 0; r < 4; ++r) { const float gate = bf2f(ldg<bf16>(mg + (size_t)r * MVW + 16 * nt)); stg<bf16>(Y + (size_t)r * DM + 16 * nt, f2bf(H[nt][r] * rstd[r] * gmv * gate)); }
        if ((nt & 3) == 3) asm volatile("" ::: "memory"); }
#endif
}

constexpr int N_PHASES = 15;
struct Args { const float* in[14]; float* out; unsigned char* ws; int ph_lo, ph_hi; };
__global__ void __launch_bounds__(NWAVES * 64, 2) mk_fwd(Args args) {
    extern __shared__ __attribute__((aligned(16))) unsigned char lds_raw[];
    LAS unsigned char* lds = (LAS unsigned char*)lds_raw;
    volatile LAS unsigned* MISC = (volatile LAS unsigned*)(lds + MISC_OFF);
    const int tid0 = threadIdx.x;
    const int wave0 = __builtin_amdgcn_readfirstlane(tid0 >> 6);
    const int G = gridDim.x, NGW = G * NWAVES;
    unsigned* ctl = (unsigned*)(args.ws + WS_CTL);
    if (tid0 < 32) MISC[tid0] = 0u;
    __syncthreads();
    XcdBarrier bar; bar.bar = ctl + CW_BAR; bar.x = 0; bar.st = nullptr;
    if (!MK_PER_PHASE) bar = xcd_barrier_post(ctl + CW_BAR, MISC + 8);
    const int lo = args.ph_lo, hi = args.ph_hi & 0xff, psub = args.ph_hi >> 8;
    const bool defer_win1 = MK_DEFERWIN1 && !MK_PER_PHASE && gridDim.x == 256 && lo == 0 && hi == N_PHASES;
    const bool defer_wout = MK_DEFERWOUT && MK_CTXSKIP && !MK_PER_PHASE && gridDim.x == 256 && lo == 0 && hi == N_PHASES;
    const bool fusel0 = MK_FUSEL0 && MK_XR16 && !MK_PER_PHASE && gridDim.x == 256 && lo == 0 && hi == N_PHASES;
    const bool fusefin = MK_FUSEFIN && MK_XR16 && !MK_PER_PHASE && G == 256 && lo == 0 && hi == N_PHASES;
#define IN(k) (lo <= (k) && (k) < hi)
#define SEAM(k) do { if (IN(k) && IN((k) + 1)) { XcdBarrier b_ = bar; asm volatile("" : "+s"(b_.bar)); xcd_barrier(b_); } } while (0)
#define PHASE_IDS_G unsigned zg_ = 0u; asm volatile("" : "+s"(zg_)); int tidg = wave0 * 64 + (int)__builtin_amdgcn_mbcnt_hi(~0u, __builtin_amdgcn_mbcnt_lo(~0u, zg_)), bidg = blockIdx.x; asm volatile("" : "+v"(tidg)); asm volatile("" : "+s"(bidg)); \
    const __attribute__((address_space(4))) Args* kag_ = (const __attribute__((address_space(4))) Args*)__builtin_amdgcn_kernarg_segment_ptr(); asm volatile("" : "+s"(kag_)); \
    Ptrs Pg; Pg.x = kag_->in[0]; Pg.c = kag_->in[1]; Pg.ctx = kag_->in[2]; Pg.c_ctx = kag_->in[3]; Pg.w_mod = kag_->in[4]; Pg.b_mod = kag_->in[5]; Pg.g_norm = kag_->in[6]; Pg.w_in = kag_->in[7]; \
    Pg.b_gate = kag_->in[8]; Pg.g_mlstm = kag_->in[9]; Pg.g_q = kag_->in[10]; Pg.g_k = kag_->in[11]; Pg.w_out = kag_->in[12]; Pg.g_final = kag_->in[13]; Pg.out = kag_->out; Pg.ws = kag_->ws; \
    const int laneg = tidg & 63, waveg = __builtin_amdgcn_readfirstlane(tidg >> 6)
#define PHASE_IDS unsigned z_ = 0u; asm volatile("" : "+s"(z_)); int tid = wave0 * 64 + (int)__builtin_amdgcn_mbcnt_hi(~0u, __builtin_amdgcn_mbcnt_lo(~0u, z_)), bid = blockIdx.x; asm volatile("" : "+v"(tid)); asm volatile("" : "+s"(bid)); \
    const __attribute__((address_space(4))) Args* ka_ = (const __attribute__((address_space(4))) Args*)__builtin_amdgcn_kernarg_segment_ptr(); asm volatile("" : "+s"(ka_)); \
    Ptrs P; P.x = ka_->in[0]; P.c = ka_->in[1]; P.ctx = ka_->in[2]; P.c_ctx = ka_->in[3]; P.w_mod = ka_->in[4]; P.b_mod = ka_->in[5]; P.g_norm = ka_->in[6]; P.w_in = ka_->in[7]; \
    P.b_gate = ka_->in[8]; P.g_mlstm = ka_->in[9]; P.g_q = ka_->in[10]; P.g_k = ka_->in[11]; P.w_out = ka_->in[12]; P.g_final = ka_->in[13]; P.out = ka_->out; P.ws = ka_->ws; \
    const int lane = tid & 63, wave = __builtin_amdgcn_readfirstlane(tid >> 6), gw = bid * NWAVES + wave; (void)lane; (void)wave; (void)gw

    if (PH_ON(0) && IN(0)) { PHASE_IDS; p0_mod(P, gw, NGW, lane); }
    const bool nobar0 = MK_NOBAR0 && !MK_PER_PHASE && lo == 0 && hi == N_PHASES;
    if (nobar0) { asm volatile("s_waitcnt vmcnt(0)" ::: "memory"); __syncthreads();
        if (threadIdx.x == 0) { __builtin_amdgcn_fence(__ATOMIC_RELEASE, "agent"); asm volatile("s_waitcnt vmcnt(0)" ::: "memory");
            __hip_atomic_fetch_add(ctl + CW_FCNT + 192, 1u, __ATOMIC_RELAXED, __HIP_MEMORY_SCOPE_AGENT); } }
    else SEAM(0);
    if (PH_ON(0) && IN(1)) { PHASE_IDS; p0_prologue(P, lds, gw, NGW, wave, lane, defer_wout, defer_win1); __syncthreads(); }

#pragma clang loop unroll(disable)
    for (int layer = 0; layer < 2; ++layer) {
        const int pb = 2 + 6 * layer;
        if (nobar0 && layer == 0) {
            if (threadIdx.x < 64) { unsigned sp = 0u;
                while (__hip_atomic_load(ctl + CW_FCNT + 192, __ATOMIC_RELAXED, __HIP_MEMORY_SCOPE_AGENT) < (unsigned)G) { __builtin_amdgcn_s_sleep(2); if (++sp > (1u << 22)) break; }
                __builtin_amdgcn_fence(__ATOMIC_ACQUIRE, "agent"); }
            asm volatile("s_waitcnt vmcnt(0)" ::: "memory");
            __syncthreads(); }
        if (PH_ON(1) && IN(pb)) { PHASE_IDS; if (fusel0 && layer == 1) p1_ctx_coop(P, lds, bid, wave, lane); else p1_norm(P, layer, gw, NGW, lane, G == 256, lds, tid); }
        const bool nobar1 = MK_NOBAR1 && fusel0 && defer_wout && layer == 1;
        if (nobar1) { asm volatile("s_waitcnt vmcnt(0)" ::: "memory"); __syncthreads();
            if (threadIdx.x == 0) { __builtin_amdgcn_fence(__ATOMIC_RELEASE, "agent"); asm volatile("s_waitcnt vmcnt(0)" ::: "memory");
                __hip_atomic_fetch_add(ctl + CW_FCNT + 200, 1u, __ATOMIC_RELAXED, __HIP_MEMORY_SCOPE_AGENT); } }
        else SEAM(pb);
        if (PH_ON(2) && IN(pb + 1)) {
            PHASE_IDS;
            const bool gl_ = MK_GATESLIGHT && layer == 1 && MK_CTXSKIP && G == 256;
            if (!gl_) p2_gates(P, layer, lds, bid, G, wave, lane, tid);
            pg8::Gemm gm{(const bf16*)(P.ws + WS_XN), (const bf16*)(P.ws + WS_WINT) + (size_t)layer * NIN * DM, MROWS, NIN, DM, DM};
            RowOrder S; if (layer == 1 && MK_CTXSKIP) S.init(32, NIN / 256, G, bid, true, 32); else S.init(MROWS / 256, NIN / 256, G, bid, false);
            if (nobar1) { S.ctxrdy = ctl + CW_FCNT + 200; S.ctxneed = (unsigned)G; }
            EpiIn E{(bf16*)(P.ws + WS_MQ), (bf16*)(P.ws + WS_MK), (bf16*)(P.ws + WS_MV), (bf16*)(P.ws + WS_MG), (bf16*)(P.ws + WS_AQ), (bf16*)(P.ws + WS_AK), (bf16*)(P.ws + WS_AV), (bf16*)(P.ws + WS_ASZ)};
            pg8::gemm_phase<EpiIn, RowOrder, PG8_ALIGN, PG8_SP2>(lds, gm, S, E, tid);
            if (gl_ && bid >= 160) { __syncthreads(); PHASE_IDS_G;
                if (nobar1) { if (waveg == 0) { unsigned sp = 0u; const unsigned* rd_ = (const unsigned*)(Pg.ws + WS_CTL) + CW_FCNT + 200;
                        while (__hip_atomic_load(rd_, __ATOMIC_RELAXED, __HIP_MEMORY_SCOPE_AGENT) < 256u) { __builtin_amdgcn_s_sleep(2); if (++sp > (1u << 22)) break; }
                        __builtin_amdgcn_fence(__ATOMIC_ACQUIRE, "agent"); }
                    asm volatile("s_waitcnt vmcnt(0)" ::: "memory"); __syncthreads(); }
                p2_gates(Pg, layer, lds, bidg - 160, 96, waveg, laneg, tidg); }
            if (defer_wout && bid >= (layer == 0 ? 232 : 160)) { __syncthreads(); PHASE_IDS_G; const int fb_ = layer == 0 ? 232 : 160;
                p0_wout_items(Pg, lds, layer, (bidg - fb_) * NWAVES + waveg, (256 - fb_) * NWAVES, waveg, laneg); __syncthreads(); }
        }
        SEAM(pb + 1);
        if (PH_ON(3) && IN(pb + 2)) {
            PHASE_IDS;
            for (int it = gw; it < NSEQ * NCH; it += NGW) p2b_scan_item(P, it / NCH, it % NCH, lane);
            for (int it = gw; it < MROWS * 5; it += NGW) { const int R = it / 5, pass = it % 5;
                if (layer == 1 && pass < 4 && (R % TT) < CTXL) continue;
                p2b_qk_item(P, layer, R, pass, lane); }
            LAS bf16* scr = (LAS bf16*)(lds + wave * 9216);
            for (int it = gw; it < NBATCH * 68 * 48; it += NGW) { const int b = it / (68 * 48), r = it % (68 * 48), tb = r / 48, cbk = r % 48;
                if (cbk < 16) p2b_tr_item((const bf16*)(P.ws + WS_MK) + (size_t)(b * TT + 64 * tb) * MQW + 64 * cbk, MQW, (bf16*)(P.ws + WS_KT) + (size_t)(b * MH + (cbk >> 2)) * (4 * NCH * 16 * 512), 16, 64 * (cbk & 3), 2 * tb, scr, lane);
                else { const int cbv = cbk - 16; p2b_tr_item((const bf16*)(P.ws + WS_MV) + (size_t)(b * TT + 64 * tb) * MVW + 64 * cbv, MVW, (bf16*)(P.ws + WS_VT) + (size_t)(b * MH + (cbv >> 3)) * (4 * NCH * 32 * 512), 32, 64 * (cbv & 7), 2 * tb, scr, lane); } }
            __syncthreads();
        }
        SEAM(pb + 2);
        if (PH_ON(4) && IN(pb + 3)) {
            unsigned* qctr = ctl + CW_QUEUE + 64 * layer; unsigned* cdone = ctl + CW_QUEUE + 64 * (2 + layer);
            { PHASE_IDS;
              if (PH_ON(8) && bid < 32 && !(psub & 1)) { p3_chain_block(P, bid, wave, lane, lds);
                  __builtin_amdgcn_fence(__ATOMIC_RELEASE, "agent");
                  asm volatile("s_waitcnt vmcnt(0)" ::: "memory");
                  if (lane == 0) __hip_atomic_fetch_add(cdone, 1u, __ATOMIC_RELAXED, __HIP_MEMORY_SCOPE_AGENT); }
            }
            if (PH_ON(10)) {
            PHASE_IDS;
            constexpr int NFULL = 512 - NSPLIT, NPARTS = NPART * NSPLIT;
            const int nA = NFULL + NPARTS + (layer == 0 ? 32 : 0), jlo = layer == 0 ? 0 : 2, nj = NCH - jlo, nM = (psub & 2) ? 0 : NBATCH * MH * nj;
            unsigned* tickets = ctl + CW_QUEUE + 64 * 24 + 64 * layer;
            bool m2_ready = false;
            bool conv_todo = defer_win1 && layer == 0; int npop = 0; const int cslot = bid < 32 ? 0 : (bid & 3);
#define WIN1_SHARE() do { __syncthreads(); { PHASE_IDS_G; p0_win1_items(Pg, lds, bidg * NWAVES + waveg, 256 * NWAVES, waveg, laneg); } __syncthreads(); conv_todo = false; } while (0)
            for (;;) {
                if (conv_todo && npop == cslot) WIN1_SHARE();
                ++npop;
                unsigned zq_ = 0u; asm volatile("" : "+s"(zq_));
                const int tq = wave * 64 + (int)__builtin_amdgcn_mbcnt_hi(~0u, __builtin_amdgcn_mbcnt_lo(~0u, zq_));
                __syncthreads();
                if (tq == 0) MISC[0] = __hip_atomic_fetch_add(qctr, 1u, __ATOMIC_RELAXED, __HIP_MEMORY_SCOPE_AGENT);
                __syncthreads();
                const int qi = __builtin_amdgcn_readfirstlane((int)MISC[0]);
                if (qi >= nA + nM) break;
                int idx = qi;
                if (MK_QORDER == 1 && qi >= NFULL) { const int nC = nA - NFULL - NPARTS;
                    idx = qi < NFULL + nM ? nA + (qi - NFULL) : qi < NFULL + nM + NPARTS ? NFULL + (qi - NFULL - nM) : NFULL + NPARTS + (qi - NFULL - nM - NPARTS); (void)nC; }
#if MK_PER_PHASE
                if ((psub & 8) && idx >= 480 && idx < 512) continue;
                if ((psub & 16) && idx < 480) continue;
#endif
                if (idx < nA) {
                    int b, head, qrow0, seq, k0 = 0, pidx = 0; float* part = nullptr; unsigned* tick = nullptr;
                    int lu = idx;
                    if (idx >= NFULL && idx < NFULL + NPARTS) { const int hh = idx - NFULL, orph = hh / NPART; pidx = hh % NPART; lu = NFULL + orph;
                        part = (float*)(P.ws + WS_APART) + (size_t)orph * (NPART * 66 * 512); tick = tickets + orph; }
                    if (idx < NFULL + NPARTS) { b = lu >> 8; const int rem = lu & 255, kvh_ = rem >> 6, r2 = rem & 63, qb = r2 >> 2, gq = r2 & 3; head = kvh_ * 4 + gq; qrow0 = b * TT + CTXL + 256 * qb;
                        if (part) { k0 = 64 * (pidx < 2 ? 18 * pidx : 4 + 16 * pidx); seq = 64 * (pidx < 2 ? 18 : 16); } else seq = TT; }
                    else { const int r = idx - (NFULL + NPARTS); b = r >> 4; head = r & 15; qrow0 = b * TT; seq = CTXL; }
                    const int kvh = head >> 2;
                    unsigned za_ = 0u; asm volatile("" : "+s"(za_));
                    int tid_a = wave * 64 + (int)__builtin_amdgcn_mbcnt_hi(~0u, __builtin_amdgcn_mbcnt_lo(~0u, za_)); asm volatile("" : "+v"(tid_a));
                    const int ln_ = tid_a & 63;
                    float gqm = fmaxf(fabsf(ldg<float>(P.g_q + (size_t)layer * HD + ln_)), fabsf(ldg<float>(P.g_q + (size_t)layer * HD + 64 + ln_)));
                    float gkm = fmaxf(fabsf(ldg<float>(P.g_k + (size_t)layer * HD + ln_)), fabsf(ldg<float>(P.g_k + (size_t)layer * HD + 64 + ln_)));
#pragma unroll
                    for (int o_ = 1; o_ < 64; o_ <<= 1) { gqm = fmaxf(gqm, shl_xor(gqm, o_, ln_)); gkm = fmaxf(gkm, shl_xor(gkm, o_, ln_)); }
                    const float mfix = __int_as_float(__builtin_amdgcn_readfirstlane(__float_as_int(128.f * 1.02f * gqm * gkm)));
                    const bool usefix = MK_FIXM && (2.f * mfix * 0.088388347648318440f < 60.f);
                    if (usefix)
                    att::attn_dense_body<true>((const bf16*)(P.ws + WS_AQN) + (size_t)qrow0 * AQW + head * HD, (const bf16*)(P.ws + WS_AKN) + (size_t)(b * TT + k0) * AKW + kvh * HD,
                                         (const bf16*)(P.ws + WS_AV) + (size_t)(b * TT + k0) * AKW + kvh * HD, (const bf16*)(P.ws + WS_ASZ) + (size_t)qrow0 * AQW + head * HD,
                                         (bf16*)(P.ws + WS_Y) + (size_t)qrow0 * DM + MVW + head * HD, seq, (char*)lds_raw, tid_a, part, tick, pidx, MISC + 1, mfix, (psub & 32) != 0);
                    else
                    att::attn_dense_body<false>((const bf16*)(P.ws + WS_AQN) + (size_t)qrow0 * AQW + head * HD, (const bf16*)(P.ws + WS_AKN) + (size_t)(b * TT + k0) * AKW + kvh * HD,
                                         (const bf16*)(P.ws + WS_AV) + (size_t)(b * TT + k0) * AKW + kvh * HD, (const bf16*)(P.ws + WS_ASZ) + (size_t)qrow0 * AQW + head * HD,
                                         (bf16*)(P.ws + WS_Y) + (size_t)qrow0 * DM + MVW + head * HD, seq, (char*)lds_raw, tid_a, part, tick, pidx, MISC + 1, 0.f, (psub & 32) != 0);
                } else {
                    if (!m2_ready) {
                        if (wave == 0) { unsigned sp = 0u;
                            while (__hip_atomic_load(cdone, __ATOMIC_RELAXED, __HIP_MEMORY_SCOPE_AGENT) < 256u) { __builtin_amdgcn_s_sleep(4); if (++sp > (1u << 22)) break; }
                            __builtin_amdgcn_fence(__ATOMIC_ACQUIRE, "agent"); }
                        asm volatile("s_waitcnt vmcnt(0)" ::: "memory");
                        __syncthreads();
                        m2_ready = true;
                    }
                    const int u = idx - nA, j = jlo + u % nj, bh = u / nj;
                    unsigned zm_ = 0u; asm volatile("" : "+s"(zm_));
                    const int tm = wave * 64 + (int)__builtin_amdgcn_mbcnt_hi(~0u, __builtin_amdgcn_mbcnt_lo(~0u, zm_));
                    p4_m2_unit(P, layer, bh >> 2, bh & 3, j, wave, tm, lds, (psub & 32) != 0);
                }
            }
            if (conv_todo) WIN1_SHARE();
#undef WIN1_SHARE
            }
        }
        if (IN(pb + 3) && IN(pb + 5)) { XcdBarrier b_ = bar; asm volatile("" : "+s"(b_.bar)); xcd_barrier(b_); }
        if (PH_ON(6) && IN(pb + 5)) {
            PHASE_IDS;
            const bool ksplit = (layer == 0 && G == 256);
            pg8::Gemm gm{(const bf16*)(P.ws + WS_Y), (const bf16*)(P.ws + WS_WOUTT) + (size_t)layer * DM * DM, MROWS, DM, DM, DM};
            if (fusel0 && layer == 0) {
                EpiOutNormL0 EL{P.x, (const float*)(P.ws + WS_CTL + CTL_MOD_OFF), P.b_mod, (bf16*)(P.ws + WS_XR1), (bf16*)(P.ws + WS_XN),
                                (const float*)(P.ws + WS_CTL + CTL_MOD_OFF) + (size_t)3 * MODW, P.b_mod + MODW, P.g_norm + DM, (float*)(P.ws + WS_FSLOT), ctl + CW_FCNT + 64};
                PanelOrder SA{bid, 0}; pg8::gemm_phase<EpiOutNormL0, PanelOrder, false, PG8_SP2>(lds, gm, SA, EL, tid);
                __syncthreads();
                PanelOrder SB{bid, 1}; pg8::gemm_phase<EpiOutNormL0, PanelOrder, false, PG8_SP2>(lds, gm, SB, EL, tid);
                __syncthreads();
            } else if (fusefin && layer == 1) {
                EpiOutNorm EN{(const bf16*)(P.ws + WS_XR1), P.out, (const float*)(P.ws + WS_CTL + CTL_MOD_OFF) + (size_t)layer * 3 * MODW, P.b_mod + (size_t)layer * MODW, P.g_final,
                              (float*)(P.ws + WS_FSLOT), ctl + CW_FCNT};
                PanelOrder SA{bid, 0}; pg8::gemm_phase<EpiOutNorm, PanelOrder, false, PG8_SP2>(lds, gm, SA, EN, tid);
                __syncthreads();
                PanelOrder SB{bid, 1}; pg8::gemm_phase<EpiOutNorm, PanelOrder, false, PG8_SP2>(lds, gm, SB, EN, tid);
            } else {
            RowOrder S; S.init((layer == 1 || ksplit) ? 32 : 34, DM / 256, G, bid, layer == 1 || ksplit);
            EpiOut E{layer, P.x, P.ctx, (const float*)(P.ws + WS_XR1), (float*)(P.ws + WS_XR1), P.out, (const float*)(P.ws + WS_CTL + CTL_MOD_OFF) + (size_t)layer * 3 * MODW, P.b_mod + (size_t)layer * MODW};
            pg8::gemm_phase<EpiOut, RowOrder, PG8_ALIGN, PG8_SP2>(lds, gm, S, E, tid);
            }
            if (ksplit) {
                const int ks = bid & 7;
                pg8::Gemm g2{(const bf16*)(P.ws + WS_Y) + ks * 512, (const bf16*)(P.ws + WS_WOUTT) + ks * 512, MROWS, DM, 512, DM};
                KSplitOrder S2{bid};
                EpiPart E2{(float*)(P.ws + WS_PART), ks};
                pg8::gemm_phase<EpiPart, KSplitOrder, false, PG8_SP2>(lds, g2, S2, E2, tid);
            }
        }
        if (!(fusefin && layer == 1)) SEAM(pb + 5);
    }
    if (PH_ON(7) && IN(14) && !fusefin) {
        PHASE_IDS;
        for (int R = gw; R < NBATCH * SEQ; R += NGW) {
            float* row = P.out + (size_t)R * DM + 4 * lane;
            f32x4 v[16]; float s = 0.f;
#pragma unroll
            for (int j = 0; j < 16; ++j) { v[j] = ldg<f32x4>(row + 256 * j); s += (v[j][0] * v[j][0] + v[j][1] * v[j][1]) + (v[j][2] * v[j][2] + v[j][3] * v[j][3]); }
            const float rstd = rsqrtf(wave_sum(s, lane) * (1.f / DM) + EPS);
#pragma unroll
            for (int j = 0; j < 16; ++j) { const f32x4 g4 = ldg<f32x4>(P.g_final + 4 * lane + 256 * j); stg<f32x4>(row + 256 * j, v[j] * rstd * g4); }
        }
    }
#undef IN
#undef SEAM
}

__global__ void probe_set(unsigned* q, unsigned v0, unsigned v1, unsigned v2) { if (threadIdx.x == 0) { q[0] = v0; q[64] = v1; if (v2) { q[128] = v2; q[192] = v2; } } }
extern "C" void kernel_launch(void* const* d_in, const int* in_sizes, int n_in, void* d_out, int out_size, void* d_ws, size_t ws_size, hipStream_t stream) {
    static int grid = 0;
    if (grid == 0) {
        if (n_in != 14 || out_size != NBATCH * SEQ * DM || ws_size < WS_END) { fprintf(stderr, "kernel_launch: shape mismatch (n_in %d out %d ws %zu need %zu)\n", n_in, out_size, ws_size, (size_t)WS_END); grid = -1; return; }
        int dev = 0, cus = 0, per_cu = 0;
        if (hipGetDevice(&dev) != hipSuccess || hipDeviceGetAttribute(&cus, hipDeviceAttributeMultiprocessorCount, dev) != hipSuccess) { grid = -1; return; }
        if (hipFuncSetAttribute((const void*)mk_fwd, hipFuncAttributeMaxDynamicSharedMemorySize, LDS_BYTES) != hipSuccess) { fprintf(stderr, "kernel_launch: hipFuncSetAttribute failed\n"); grid = -1; return; }
        if (hipOccupancyMaxActiveBlocksPerMultiprocessor(&per_cu, (const void*)mk_fwd, NWAVES * 64, LDS_BYTES) != hipSuccess || per_cu < 1)
            fprintf(stderr, "kernel_launch: occupancy query reports %d blocks per CU\n", per_cu);
        (void)hipGetLastError();
        grid = cus > 0 ? cus : 256;
    }
    if (grid < 0) return;
    if (hipMemsetAsync((char*)d_ws + WS_CTL, 0, CTL_BYTES, stream) != hipSuccess) { fprintf(stderr, "kernel_launch: memset failed\n"); return; }
    Args a{};
    for (int i = 0; i < 14; ++i) a.in[i] = (const float*)d_in[i];
    a.out = (float*)d_out; a.ws = (unsigned char*)d_ws;
#if MK_PER_PHASE
    for (int ph = 0; ph < N_PHASES; ++ph) {
        const int kind = ph == 1 ? 0 : ph == 0 ? 11 : ph == 14 ? 7 : 1 + (ph - 2) % 6;
        const int nrep = 1 + MK_NREP * REP_ON(kind);
        for (int rep = 0; rep < nrep; ++rep) {
            if (MK_REP && kind == 4) { hipMemsetAsync((char*)d_ws + WS_CTL + CW_QUEUE * 4, (rep && MK_SUB == 1) ? 0x7f : 0, 1024, stream); hipMemsetAsync((char*)d_ws + WS_CTL + (CW_QUEUE + 64 * 24) * 4, 0, 512, stream);
                if (rep && MK_SUB == 2) hipLaunchKernelGGL(probe_set, dim3(1), dim3(64), 0, stream, (unsigned*)((char*)d_ws + WS_CTL) + CW_QUEUE, 544u, 512u, 0u);
                if (rep && MK_SUB == 9) hipLaunchKernelGGL(probe_set, dim3(1), dim3(64), 0, stream, (unsigned*)((char*)d_ws + WS_CTL) + CW_QUEUE, 544u, 512u, 256u); }
            a.ph_lo = ph; a.ph_hi = (ph + 1) | ((rep && MK_SUB == 3) ? (3 << 8) : (rep && MK_SUB == 4) ? (2 << 8) : (rep && MK_SUB == 6) ? (8 << 8) : (rep && MK_SUB == 7) ? (16 << 8) : (rep && MK_SUB == 8) ? (10 << 8) : (rep && MK_SUB == 9) ? (1 << 8) : (rep && MK_SUB == 10) ? (32 << 8) : 0); hipLaunchKernelGGL(mk_fwd, dim3(grid), dim3(NWAVES * 64), LDS_BYTES, stream, a); } }
#else
    a.ph_lo = 0; a.ph_hi = N_PHASES;
    hipLaunchKernelGGL(mk_fwd, dim3(grid), dim3(NWAVES * 64), LDS_BYTES, stream, a);
#endif
    const hipError_t le = hipPeekAtLastError();
    if (le != hipSuccess) fprintf(stderr, "kernel_launch: launch failed: %s\n", hipGetErrorName(le));
}
```

```cpp
#include <hip/hip_runtime.h>
#include <cstdio>
#include <cstdint>
namespace pg8 {
#define PG8_LAS __attribute__((address_space(3)))
typedef unsigned short bf16_t;
typedef short bf16x8 __attribute__((ext_vector_type(8)));
typedef float f32x4 __attribute__((ext_vector_type(4)));
typedef unsigned u32x4 __attribute__((ext_vector_type(4)));
constexpr int BM = 256, BK = 64, HALF = 128, HTB = HALF * BK * 2  , STAGE_BYTES = 8 * HTB, NXCD = 8, WGM = 8;

__host__ __device__ __forceinline__ int lds_byte(int r, int c) { const int st = (r >> 4) * 2 + (c >> 5), rr = r & 15, cc = c & 31, ob = rr * 64 + cc * 2; return st * 1024 + (ob ^ (((ob >> 9) & 1) << 5)); }
__host__ __device__ __forceinline__ void stage_rc(int b, int& R, int& C) { const int st = b / 1024, sb = b % 1024, swz = sb ^ (((sb >> 9) & 1) << 5); R = (st >> 1) * 16 + swz / 64; C = (st & 1) * 32 + (swz % 64) / 2; }
__host__ __device__ __forceinline__ int perm32(int rho) { const int n = rho >> 4, i = rho & 15; return 8 * (i >> 2) + 4 * n + (i & 3); }

struct Unit { int pm, pn; };
struct Gemm { const bf16_t* A; const bf16_t* Bt; int M, N, K, ld; };

struct StaticOrder {
    int nM, nN, nwg, G, c;
    __host__ __device__ void init(int M, int N, int G_, int c_) { nM = M / BM; nN = N / BM; nwg = nM * nN; G = G_; c = c_; }
    __host__ __device__ bool next(int i, Unit& u) const {
        const long L = (long)i * G + c; if (L >= nwg) return false;
        int wgid = (int)L; { const int q = nwg / NXCD, r = nwg % NXCD, xcd = wgid % NXCD, off = wgid / NXCD; wgid = (xcd < r ? xcd * (q + 1) : r * (q + 1) + (xcd - r) * q) + off; }
        const int nig = WGM * nN, gid = wgid / nig, fm = gid * WGM, gsz = (nM - fm) < WGM ? (nM - fm) : WGM;
        u.pm = fm + ((wgid % nig) % gsz); u.pn = (wgid % nig) / gsz; return true;
    }
    __device__ __forceinline__ void a_ready(const Unit&) const {}
    __device__ __forceinline__ void done(const Unit&) const {}
};

__device__ __forceinline__ unsigned cvt_pk_bf16(float lo, float hi) { unsigned r; asm volatile("v_cvt_pk_bf16_f32 %0, %1, %2" : "=v"(r) : "v"(lo), "v"(hi)); return r; }
typedef float f32x2 __attribute__((ext_vector_type(2)));
template <class Epi, class Sched, bool ALIGN_EPI = false, bool SP2 = false>
__device__ __forceinline__ void gemm_phase(PG8_LAS unsigned char* lds, const Gemm g, const Sched& S, const Epi& E, const int tid_in) {
    const int tid = tid_in, wid = __builtin_amdgcn_readfirstlane(tid >> 6), lane = tid & 63, wr = wid >> 2, wc = wid & 3, fr = lane & 15, fq = lane >> 4;
    const int K = g.ld, nt = g.K / BK;
    unsigned voffA[2], voffB[2];
#pragma unroll
    for (int i = 0; i < 2; ++i) { int R, C; stage_rc(tid * 16 + i * 8192, R, C); const int Rb = Epi::PERM ? ((R & ~31) + perm32(R & 31)) : R;
        voffA[i] = (unsigned)(R * K + C) * 2u; voffB[i] = (unsigned)(Rb * K + C) * 2u; }
    const size_t kstep = (size_t)(BK * 2);
    const size_t hstep = (size_t)HALF * K * 2;
    const size_t tstep = 2 * hstep;
    const unsigned ldsw = (unsigned)wid * 1024u;
    const int aoff = lds_byte(wr * 64 + fr, fq * 8), boff = lds_byte(wc * 32 + fr, fq * 8);
#define PG8_SA(b, h) (((b) * 2 + (h)) * HTB)
#define PG8_SB(b, h) ((4 + (b) * 2 + (h)) * HTB)
#define PG8_STAGE(bufoff, gbase, voff) do { _Pragma("unroll") for (int _i = 0; _i < 2; ++_i) \
        __builtin_amdgcn_global_load_lds((const unsigned*)((const char*)(gbase) + (voff)[_i]), (PG8_LAS unsigned*)(lds + (bufoff) + ldsw + _i * 8192), 16, 0, 0); } while (0)
#define PG8_LDA(dst, b, h) do { _Pragma("unroll") for (int m = 0; m < 4; ++m) _Pragma("unroll") for (int k = 0; k < 2; ++k) dst[m][k] = *(const PG8_LAS bf16x8*)(lds + PG8_SA(b, h) + aoff + m * 2048 + k * 1024); } while (0)
#define PG8_LDB(dst, b, h) do { _Pragma("unroll") for (int n = 0; n < 2; ++n) _Pragma("unroll") for (int k = 0; k < 2; ++k) dst[n][k] = *(const PG8_LAS bf16x8*)(lds + PG8_SB(b, h) + boff + n * 2048 + k * 1024); } while (0)
#define PG8_MMA(ai, bj, At, Bt) do { __builtin_amdgcn_s_setprio(1); _Pragma("unroll") for (int m = 0; m < 4; ++m) _Pragma("unroll") for (int n = 0; n < 2; ++n) _Pragma("unroll") for (int k = 0; k < 2; ++k) \
        acc[ai][bj][m][n] = __builtin_amdgcn_mfma_f32_16x16x32_bf16(Bt[n][k], At[m][k], acc[ai][bj][m][n], 0, 0, 0); __builtin_amdgcn_s_setprio(0); } while (0)
#define PG8_WAIT_V(n) asm volatile("s_waitcnt vmcnt(" #n ")" ::: "memory")
#define PG8_WAIT_L(n) asm volatile("s_waitcnt lgkmcnt(" #n ")" ::: "memory")
#define PG8_BAR __builtin_amdgcn_s_barrier()
#define PG8_SCHED __builtin_amdgcn_sched_barrier(0)
    Unit cur, nxt; int ui = 0;
    if (!S.next(0, cur)) return;
    f32x4 acc[2][2][4][2];
#pragma unroll
    for (int a = 0; a < 2; ++a)
#pragma unroll
        for (int b = 0; b < 2; ++b)
#pragma unroll
            for (int m = 0; m < 4; ++m)
#pragma unroll
                for (int n = 0; n < 2; ++n) acc[a][b][m][n] = (f32x4){0.f, 0.f, 0.f, 0.f};
    bf16x8 At[4][2], B0[2][2], B1[2][2];
    const char* cA = (const char*)g.A + (size_t)cur.pm * tstep; const char* cB = (const char*)g.Bt + (size_t)cur.pn * tstep;
    S.a_ready(cur);
    if constexpr (SP2) {
        PG8_STAGE(PG8_SB(0, 0), cB, voffB); PG8_STAGE(PG8_SB(0, 1), cB + hstep, voffB); PG8_STAGE(PG8_SA(0, 0), cA, voffA); PG8_STAGE(PG8_SA(0, 1), cA + hstep, voffA);
        if (wr == 1) PG8_BAR;
        PG8_WAIT_V(2); PG8_BAR;
        PG8_STAGE(PG8_SB(1, 0), cB + kstep, voffB); PG8_STAGE(PG8_SA(1, 0), cA + kstep, voffA); PG8_STAGE(PG8_SB(1, 1), cB + hstep + kstep, voffB);
        PG8_WAIT_V(6); PG8_BAR;
    } else {
        PG8_STAGE(PG8_SB(0, 0), cB, voffB); PG8_STAGE(PG8_SA(0, 0), cA, voffA); PG8_STAGE(PG8_SB(0, 1), cB + hstep, voffB); PG8_STAGE(PG8_SA(0, 1), cA + hstep, voffA);
        if (wr == 1) PG8_BAR;
        PG8_WAIT_V(4); PG8_BAR;
        PG8_STAGE(PG8_SB(1, 0), cB + kstep, voffB); PG8_STAGE(PG8_SA(1, 0), cA + kstep, voffA); PG8_STAGE(PG8_SB(1, 1), cB + hstep + kstep, voffB);
        PG8_WAIT_V(6); PG8_BAR;
    }
    for (;;) {
        const bool has_next = S.next(ui + 1, nxt);
        const char* nA = has_next ? (const char*)g.A + (size_t)nxt.pm * tstep : cA; const char* nB = has_next ? (const char*)g.Bt + (size_t)nxt.pn * tstep : cB;
        for (int t = 0; t < nt; t += 2) {
            const bool last = (t == nt - 2);
            const char* a1 = cA + (size_t)(t + 1) * kstep;
            const char* a2 = last ? nA : cA + (size_t)(t + 2) * kstep; const char* b2 = last ? nB : cB + (size_t)(t + 2) * kstep;
            const char* a3 = a2 + kstep; const char* b3 = b2 + kstep;
            if (last && has_next) S.a_ready(nxt);
            if constexpr (SP2) {
            PG8_LDB(B0, 0, 0); PG8_LDB(B1, 0, 1); PG8_SCHED; PG8_LDA(At, 0, 0); PG8_STAGE(PG8_SA(1, 1), a1 + hstep, voffA);
            PG8_WAIT_V(8); PG8_WAIT_L(0); PG8_BAR; PG8_MMA(0, 0, At, B0); PG8_MMA(0, 1, At, B1); PG8_BAR; PG8_SCHED;
            PG8_LDA(At, 0, 1); PG8_STAGE(PG8_SB(0, 0), b2, voffB); PG8_STAGE(PG8_SB(0, 1), b2 + hstep, voffB); PG8_STAGE(PG8_SA(0, 0), a2, voffA);
            PG8_WAIT_V(8); PG8_WAIT_L(0); PG8_BAR; PG8_MMA(1, 0, At, B0); PG8_MMA(1, 1, At, B1); PG8_BAR; PG8_SCHED;
            PG8_LDB(B0, 1, 0); PG8_LDB(B1, 1, 1); PG8_SCHED; PG8_LDA(At, 1, 0); PG8_STAGE(PG8_SA(0, 1), a2 + hstep, voffA);
            PG8_WAIT_V(8); PG8_WAIT_L(0); PG8_BAR; PG8_MMA(0, 0, At, B0); PG8_MMA(0, 1, At, B1); PG8_BAR; PG8_SCHED;
            PG8_LDA(At, 1, 1); PG8_STAGE(PG8_SB(1, 0), b3, voffB); PG8_STAGE(PG8_SB(1, 1), b3 + hstep, voffB); PG8_STAGE(PG8_SA(1, 0), a3, voffA);
            PG8_WAIT_V(8); PG8_WAIT_L(0); PG8_BAR; PG8_MMA(1, 0, At, B0); PG8_MMA(1, 1, At, B1); PG8_BAR; PG8_SCHED;
            } else {
            PG8_LDB(B0, 0, 0); PG8_SCHED; PG8_LDA(At, 0, 0); PG8_STAGE(PG8_SA(1, 1), a1 + hstep, voffA);
            PG8_WAIT_L(8); PG8_BAR; PG8_WAIT_L(0); PG8_MMA(0, 0, At, B0); PG8_BAR; PG8_SCHED;
            PG8_LDB(B1, 0, 1); PG8_STAGE(PG8_SB(0, 0), b2, voffB);
            PG8_BAR; PG8_WAIT_L(0); PG8_MMA(0, 1, At, B1); PG8_BAR;
            PG8_LDA(At, 0, 1); PG8_STAGE(PG8_SA(0, 0), a2, voffA);
            PG8_BAR; PG8_WAIT_L(0); PG8_MMA(1, 0, At, B0); PG8_BAR; PG8_SCHED;
            PG8_STAGE(PG8_SB(0, 1), b2 + hstep, voffB);
            PG8_WAIT_V(6); PG8_BAR; PG8_MMA(1, 1, At, B1); PG8_BAR;
            PG8_LDB(B0, 1, 0); PG8_SCHED; PG8_LDA(At, 1, 0); PG8_STAGE(PG8_SA(0, 1), a2 + hstep, voffA);
            PG8_WAIT_L(8); PG8_BAR; PG8_WAIT_L(0); PG8_MMA(0, 0, At, B0); PG8_BAR; PG8_SCHED;
            PG8_LDB(B1, 1, 1); PG8_STAGE(PG8_SB(1, 0), b3, voffB);
            PG8_BAR; PG8_WAIT_L(0); PG8_MMA(0, 1, At, B1); PG8_BAR;
            PG8_LDA(At, 1, 1); PG8_STAGE(PG8_SA(1, 0), a3, voffA);
            PG8_BAR; PG8_WAIT_L(0); PG8_MMA(1, 0, At, B0); PG8_BAR; PG8_SCHED;
            PG8_STAGE(PG8_SB(1, 1), b3 + hstep, voffB);
            PG8_WAIT_V(6); PG8_BAR; PG8_MMA(1, 1, At, B1); PG8_BAR;
            }
        }
        if constexpr (ALIGN_EPI) { if (wr == 0) PG8_BAR; }
        if constexpr (!Epi::AFTER_DRAIN) { E(acc, cur, wr, wc, fr, fq); S.done(cur); }
        if (!has_next) break;
#pragma unroll
        for (int a = 0; a < 2; ++a)
#pragma unroll
            for (int b = 0; b < 2; ++b)
#pragma unroll
                for (int m = 0; m < 4; ++m)
#pragma unroll
                    for (int n = 0; n < 2; ++n) acc[a][b][m][n] = (f32x4){0.f, 0.f, 0.f, 0.f};
        cur = nxt; cA = nA; cB = nB; ++ui;
        if constexpr (ALIGN_EPI) { if (wr == 1) PG8_BAR; }
    }
    PG8_WAIT_V(0);
    if constexpr (!ALIGN_EPI) { if (wr == 0) PG8_BAR; }
    PG8_BAR;
    if constexpr (Epi::AFTER_DRAIN) { E.fused(acc, cur, wr, wc, fr, fq, lds, wid, lane); S.done(cur); }
#undef PG8_SA
#undef PG8_SB
#undef PG8_STAGE
#undef PG8_LDA
#undef PG8_LDB
#undef PG8_MMA
#undef PG8_WAIT_V
#undef PG8_WAIT_L
#undef PG8_BAR
#undef PG8_SCHED
}
}

#ifndef PG8_SP2
#define PG8_SP2 true
#endif
#ifndef PG8_ALIGN
#define PG8_ALIGN true
#endif
#ifndef MK_MASK
#define MK_MASK 0x7ff
#endif
#define PH_ON(k) (((MK_MASK) >> (k)) & 1)
#ifndef MK_REP
#define MK_REP 0
#endif
#define REP_ON(k) (((MK_REP) >> (k)) & 1)
#ifndef MK_NREP
#define MK_NREP 1
#endif
#ifndef MK_SUB
#define MK_SUB 0
#endif
#ifndef MK_NSPLIT
#define MK_NSPLIT 64
#endif
#ifndef MK_DEFERWIN1
#define MK_DEFERWIN1 1
#endif
#ifndef MK_DEFERWOUT
#define MK_DEFERWOUT 1
#endif
#ifndef MK_GATESLIGHT
#define MK_GATESLIGHT 1
#endif
#ifndef MK_FUSEL0
#define MK_FUSEL0 1
#endif
#ifndef MK_FUSEFIN
#define MK_FUSEFIN 1
#endif
#ifndef MK_FIXM
#define MK_FIXM 1
#endif
#ifndef MK_EPILDS
#define MK_EPILDS 1
#endif
#ifndef MK_XR16
#define MK_XR16 1
#endif
#ifndef MK_CTXSKIP
#define MK_CTXSKIP 1
#endif
#ifndef MK_QORDER
#define MK_QORDER 1
#endif
#ifndef MK_M2RING
#define MK_M2RING 4
#endif
#ifndef MK_PER_PHASE
#define MK_PER_PHASE 0
#endif

#define GAS __attribute__((address_space(1)))
#define LAS __attribute__((address_space(3)))
typedef unsigned short bf16;
typedef short bf16x8 __attribute__((ext_vector_type(8)));
typedef short s16x4 __attribute__((ext_vector_type(4)));
typedef float f32x2 __attribute__((ext_vector_type(2)));
typedef float f32x4 __attribute__((ext_vector_type(4)));
typedef float f32x8 __attribute__((ext_vector_type(8)));
typedef float f32x16 __attribute__((ext_vector_type(16)));
typedef unsigned u32x2 __attribute__((ext_vector_type(2)));
typedef unsigned u32x4 __attribute__((ext_vector_type(4)));

constexpr int DM = 4096, NBATCH = 2, SEQ = 4096, CTXL = 256, TT = SEQ + CTXL, MROWS = NBATCH * TT;
constexpr int IN_COLS = 13328, NIN = 13312, MODW = 3 * DM;
constexpr int MH = 4, MDK = 256, MDV = 512, CHK = 128, NCH = TT / CHK, MQW = MH * MDK, MVW = MH * MDV;
constexpr int AHQ = 16, AKVH = 4, HD = 128, AQW = AHQ * HD, AKW = AKVH * HD;
constexpr float EPS = 1e-6f;
constexpr int NSEQ = 16;
constexpr int NPANEL = MROWS / 16;
static_assert(TT == 4352 && MROWS == 8704 && NCH == 34 && TT % 256 == 0, "shapes");
constexpr int SC_MQ = 0, SC_MK = 1024, SC_MV = 2048, SC_MO = 4096, SC_MZ = 6144, SC_G = 8192, SC_AQ = 8208, SC_AK = 10256, SC_AV = 10768, SC_AZ = 11280;
constexpr int DN_MQ = 0, DN_MK = 1024, DN_MV = 2048, DN_OZ = 4096, DN_AQ = 8192, DN_AK = 10240, DN_AV = 10752, DN_AZ = 11264;

constexpr size_t al256(size_t x) { return (x + 255) & ~(size_t)255; }
constexpr size_t WS_CTL = 0, CTL_BYTES = 1u << 20;
constexpr int CW_BAR = 4096, CW_QUEUE = 8192;
constexpr size_t CTL_MOD_OFF = 512 * 1024;
static_assert(CTL_MOD_OFF + 2 * 3 * MODW * 4 <= CTL_BYTES, "ctl");
constexpr size_t WS_WINT  = CTL_BYTES;
constexpr size_t WS_WGT   = al256(WS_WINT + (size_t)2 * NIN * DM * 2);
constexpr size_t WS_WOUTT = al256(WS_WGT + (size_t)2 * 16 * DM * 2);
constexpr size_t WS_ROPE  = al256(WS_WOUTT + (size_t)2 * DM * DM * 2);
constexpr size_t WS_XN    = al256(WS_ROPE + 2 * 64 * 32 * 4);
constexpr size_t WS_MQ    = al256(WS_XN + (size_t)MROWS * DM * 2);
constexpr size_t WS_MK    = al256(WS_MQ + (size_t)MROWS * MQW * 2);
constexpr size_t WS_MV    = al256(WS_MK + (size_t)MROWS * MQW * 2);
constexpr size_t WS_MG    = al256(WS_MV + (size_t)MROWS * MVW * 2);
constexpr size_t WS_AQ    = al256(WS_MG + (size_t)MROWS * MVW * 2);
constexpr size_t WS_AK    = al256(WS_AQ + (size_t)MROWS * AQW * 2);
constexpr size_t WS_AV    = al256(WS_AK + (size_t)MROWS * AKW * 2);
constexpr size_t WS_ASZ   = al256(WS_AV + (size_t)MROWS * AKW * 2);
constexpr size_t WS_GATES = al256(WS_ASZ + (size_t)MROWS * AQW * 2);
constexpr size_t WS_VT    = al256(WS_GATES + (size_t)MROWS * 16 * 4);
constexpr size_t WS_KT    = al256(WS_VT + (size_t)NBATCH * MH * MDV * TT * 2);
constexpr size_t WS_SCAN  = al256(WS_KT + (size_t)NBATCH * MH * MDK * TT * 2);
constexpr size_t SCAN_ARR = (size_t)NSEQ * TT * 4;
constexpr size_t WS_ACH   = al256(WS_SCAN + 5 * SCAN_ARR);
constexpr size_t WS_CST   = al256(WS_ACH + (size_t)4 * NSEQ * NCH * 4);
constexpr size_t WS_NST   = al256(WS_CST + (size_t)NSEQ * NCH * MDV * MDK * 2);
constexpr size_t WS_Y     = al256(WS_NST + (size_t)NSEQ * NCH * MDK * 4);
constexpr size_t WS_XR1   = al256(WS_Y + (size_t)MROWS * DM * 2);
constexpr size_t WS_AQN   = al256(WS_XR1 + (size_t)MROWS * DM * 4);
constexpr size_t WS_AKN   = al256(WS_AQN + (size_t)MROWS * AQW * 2);
constexpr size_t WS_PART  = al256(WS_AKN + (size_t)MROWS * AKW * 2);
constexpr int NSPLIT = MK_NSPLIT, NPART = 4;
constexpr size_t WS_APART = al256(WS_PART + (size_t)8 * NBATCH * CTXL * DM * 4);
constexpr size_t WS_FSLOT = al256(WS_APART + (size_t)(NSPLIT > 0 ? NSPLIT : 1) * NPART * 66 * 512 * 4);
constexpr size_t WS_END   = al256(WS_FSLOT + (size_t)34 * 16 * 256 * 4);
constexpr int CW_FCNT = 8192 + 64 * 28;

constexpr int LDS_BYTES = 147456;
constexpr int MISC_OFF = 143360;
constexpr int NWAVES = 8;

__device__ __forceinline__ float bflo(unsigned w) { return __uint_as_float(w << 16); }
__device__ __forceinline__ float bfhi(unsigned w) { return __uint_as_float(w & 0xffff0000u); }
__device__ __forceinline__ float bf2f(bf16 h) { return __uint_as_float((unsigned)h << 16); }
__device__ __forceinline__ unsigned cvtpk(float lo, float hi) { unsigned r; asm("v_cvt_pk_bf16_f32 %0, %1, %2" : "=v"(r) : "v"(lo), "v"(hi)); return r; }
__device__ __forceinline__ bf16 f2bf(float f) { return (bf16)(cvtpk(f, 0.f) & 0xffffu); }
__device__ __forceinline__ float shl_idx(float v, int src_lane) { return __int_as_float(__builtin_amdgcn_ds_bpermute(src_lane << 2, __float_as_int(v))); }
__device__ __forceinline__ float shl_xor(float v, int m, int lane) { return shl_idx(v, lane ^ m); }
__device__ __forceinline__ float shl_up(float v, int o, int lane) { return shl_idx(v, lane >= o ? lane - o : lane); }
__device__ __forceinline__ float wave_sum(float v, int lane) {
#pragma unroll
    for (int o = 1; o < 64; o <<= 1) v += shl_xor(v, o, lane);
    return v;
}
__device__ __forceinline__ float sigmoidf_fast(float x) { return __builtin_amdgcn_rcpf(1.0f + __builtin_amdgcn_exp2f(-1.4426950408889634f * x)); }
__device__ __forceinline__ f32x4 mfma16(bf16x8 a, bf16x8 b, f32x4 c) { return __builtin_amdgcn_mfma_f32_16x16x32_bf16(a, b, c, 0, 0, 0); }
template <class T> __device__ __forceinline__ T ldg(const void* p) { return *(const GAS T*)p; }
template <class T> __device__ __forceinline__ void stg(void* p, const T v) { *(GAS T*)p = v; }
__device__ __forceinline__ void stg_wt8(void* p, const u32x2 v) { __hip_atomic_store((GAS unsigned long long*)p, ((unsigned long long)v.y << 32) | v.x, __ATOMIC_RELAXED, __HIP_MEMORY_SCOPE_AGENT); }
__device__ __forceinline__ void stg_wt4(void* p, const unsigned v) { __hip_atomic_store((GAS unsigned*)p, v, __ATOMIC_RELAXED, __HIP_MEMORY_SCOPE_AGENT); }
#define LDS_WAIT() asm volatile("s_waitcnt lgkmcnt(0)" ::: "memory")
#define VM_WAIT() asm volatile("s_waitcnt vmcnt(0)" ::: "memory")

#define XB_TMO      128
#define XB_XCNT(j)  (256  + 64 * (j))
#define XB_XSUB(j)  (1280 + 64 * (j))
#define XB_XGEN(j)  (2304 + 64 * (j))
#define XB_TOP      3328
#define XB_TOPGEN   3392
#define XCD_BAR_WORDS 3456
#define XB_SPIN_CAP (1u << 22)

__device__ __forceinline__ unsigned xb_ld(unsigned* p)              { return __hip_atomic_load(p, __ATOMIC_RELAXED, __HIP_MEMORY_SCOPE_AGENT); }
__device__ __forceinline__ unsigned xb_add(unsigned* p, unsigned v) { return __hip_atomic_fetch_add(p, v, __ATOMIC_RELAXED, __HIP_MEMORY_SCOPE_AGENT); }
__device__ __forceinline__ unsigned xb_xcc_id() { return (unsigned)__builtin_amdgcn_s_getreg((3 << 11) | 20) & 0xFu; }
#define XB_SPIN(cond, bar) do { unsigned _sp = 0; while (cond) { __builtin_amdgcn_s_sleep(1); \
    if ((++_sp & 255u) == 0u) { if (xb_ld(&(bar)[XB_TMO])) break; if (_sp > XB_SPIN_CAP) { atomicAdd(&(bar)[XB_TMO], 1u); break; } } } } while (0)

struct XcdBarrier { unsigned* bar; unsigned x; volatile LAS unsigned* st; };

__device__ __forceinline__ XcdBarrier xcd_barrier_post(unsigned* bar, volatile LAS unsigned* st) {
    XcdBarrier b; b.bar = bar; b.x = xb_xcc_id(); b.st = st;
    if (threadIdx.x == 0) (void)xb_add(&bar[XB_XCNT(b.x)], 1u);
    return b;
}
__device__ __forceinline__ void xcd_barrier_complete(unsigned* bar, unsigned x, unsigned& nloc, unsigned& nx) {
    const unsigned G = gridDim.x * gridDim.y * gridDim.z;
    unsigned sum, cnt, mine, sp = 0u;
    for (;;) {
        sum = 0u; cnt = 0u; mine = 0u;
#pragma unroll
        for (unsigned j = 0; j < 16; ++j) { const unsigned c = xb_ld(&bar[XB_XCNT(j)]); sum += c; cnt += (c > 0u) ? 1u : 0u; mine = (j == x) ? c : mine; }
        if (sum == G) break;
        __builtin_amdgcn_s_sleep(1);
        if ((++sp & 255u) == 0u) { if (xb_ld(&bar[XB_TMO])) break; if (sp > XB_SPIN_CAP) { atomicAdd(&bar[XB_TMO], 1u); break; } }
    }
    nloc = mine > 0u ? mine : 1u; nx = cnt > 0u ? cnt : 1u;
}
__device__ __forceinline__ void xcd_barrier(const XcdBarrier& b) {
    asm volatile("s_waitcnt vmcnt(0)" ::: "memory");
    __syncthreads();
    if (threadIdx.x == 0) {
        unsigned* bar = b.bar;
        __builtin_amdgcn_s_waitcnt(0);
        unsigned nloc = b.st[0], nx = b.st[1];
        if (nloc == 0u) { xcd_barrier_complete(bar, b.x, nloc, nx); b.st[0] = nloc; b.st[1] = nx; }
        const unsigned old = xb_add(&bar[XB_XSUB(b.x)], 1u);
        const unsigned gen = old / nloc;
        if (old + 1u == (gen + 1u) * nloc) {
            __builtin_amdgcn_fence(__ATOMIC_RELEASE, "agent");
            asm volatile("s_waitcnt vmcnt(0)" ::: "memory");
            const unsigned og = xb_add(&bar[XB_TOP], 1u);
            const unsigned tg = og / nx;
            if (og + 1u == (tg + 1u) * nx) xb_add(&bar[XB_TOPGEN], 1u);
            else XB_SPIN(xb_ld(&bar[XB_TOPGEN]) == tg, bar);
            __builtin_amdgcn_fence(__ATOMIC_ACQUIRE, "agent");
            xb_add(&bar[XB_XGEN(b.x)], 1u);
            asm volatile("s_waitcnt vmcnt(0)" ::: "memory");
        } else {
            XB_SPIN(xb_ld(&bar[XB_XGEN(b.x)]) == gen, bar);
            __builtin_amdgcn_fence(__ATOMIC_ACQUIRE, "agent");
            asm volatile("s_waitcnt vmcnt(0)" ::: "memory");
        }
    }
    __syncthreads();
}

struct RowOrder {
    int nM, nN, nwg, G, c; bool skipctx; int nextra;
    __device__ void init(int nM_, int nN_, int G_, int c_, bool skip, int nextra_ = 0) { nM = nM_; nN = nN_; nwg = nM * nN; G = G_; c = c_; skipctx = skip; nextra = nextra_; }
    __device__ bool next(int i, pg8::Unit& u) const {
        const long L = (long)i * G + c; if (L >= nwg + nextra) return false;
        if (L >= nwg) { const int r = (int)L - nwg, t = r >> 1; u.pm = (r & 1) ? 17 : 0; u.pn = t < 12 ? 4 + t : 28 + t; return true; }
        int wgid = (int)L; { const int q = nwg / pg8::NXCD, r = nwg % pg8::NXCD, xcd = wgid % pg8::NXCD, off = wgid / pg8::NXCD; wgid = (xcd < r ? xcd * (q + 1) : r * (q + 1) + (xcd - r) * q) + off; }
        const int nig = pg8::WGM * nN, gid = wgid / nig, fm = gid * pg8::WGM, gsz = (nM - fm) < pg8::WGM ? (nM - fm) : pg8::WGM;
        int pm = fm + ((wgid % nig) % gsz); u.pn = (wgid % nig) / gsz;
        if (skipctx) pm = pm + 1 + (pm >= 16 ? 1 : 0);
        u.pm = pm; return true;
    }
    __device__ __forceinline__ void a_ready(const pg8::Unit&) const {}
    __device__ __forceinline__ void done(const pg8::Unit&) const {}
};

struct EpiIn {
    static constexpr bool PERM = true, AFTER_DRAIN = false;
    bf16 *mq, *mk, *mv, *mg, *aq, *ak, *av, *asz;
    __device__ __forceinline__ void operator()(const f32x4 (&acc)[2][2][4][2], const pg8::Unit& u, int wr, int wc, int fr, int fq) const {
        const int row0 = u.pm * 256 + wr * 64 + fr, c8 = wc * 32 + 8 * fq, pn = u.pn;
        if (pn >= 16 && pn < 32) {
            bf16* base = mg + (size_t)row0 * MVW + (pn - 16) * 128 + c8;
#pragma unroll
            for (int ai = 0; ai < 2; ++ai)
#pragma unroll
                for (int m = 0; m < 4; ++m) {
                    float gv[8];
#pragma unroll
                    for (int n = 0; n < 2; ++n)
#pragma unroll
                        for (int e = 0; e < 4; ++e) { const float o = acc[ai][0][m][n][e], z = acc[ai][1][m][n][e]; gv[4 * n + e] = sigmoidf_fast(o) * z * sigmoidf_fast(z); }
                    u32x4 w; w.x = cvtpk(gv[0], gv[1]); w.y = cvtpk(gv[2], gv[3]); w.z = cvtpk(gv[4], gv[5]); w.w = cvtpk(gv[6], gv[7]);
                    stg<u32x4>(base + (size_t)(ai * 128 + m * 16) * MVW, w);
                }
            return;
        }
        bf16* dst; int ld, cb; float sc = 1.f; bool act = false;
        if (pn < 4)       { dst = mq; ld = MQW; cb = pn * 256; sc = 0.0625f; }
        else if (pn < 8)  { dst = mk; ld = MQW; cb = (pn - 4) * 256; }
        else if (pn < 16) { dst = mv; ld = MVW; cb = (pn - 8) * 256; }
        else if (pn < 40) { dst = aq; ld = AQW; cb = (pn - 32) * 256; }
        else if (pn < 42) { dst = ak; ld = AKW; cb = (pn - 40) * 256; }
        else if (pn < 44) { dst = av; ld = AKW; cb = (pn - 42) * 256; }
        else              { dst = asz; ld = AQW; cb = (pn - 44) * 256; act = true; }
        bf16* base = dst + (size_t)row0 * ld + cb + c8;
#pragma unroll
        for (int ai = 0; ai < 2; ++ai)
#pragma unroll
            for (int m = 0; m < 4; ++m)
#pragma unroll
                for (int bj = 0; bj < 2; ++bj) {
                    f32x4 v0 = acc[ai][bj][m][0] * sc, v1 = acc[ai][bj][m][1] * sc;
                    if (act) {
#pragma unroll
                        for (int e = 0; e < 4; ++e) { v0[e] = v0[e] * sigmoidf_fast(v0[e]); v1[e] = v1[e] * sigmoidf_fast(v1[e]); }
                    }
                    u32x4 w; w.x = cvtpk(v0[0], v0[1]); w.y = cvtpk(v0[2], v0[3]); w.z = cvtpk(v1[0], v1[1]); w.w = cvtpk(v1[2], v1[3]);
                    stg<u32x4>(base + (size_t)(ai * 128 + m * 16) * ld + bj * 128, w);
                }
    }
};

struct EpiOut {
    static constexpr bool PERM = true, AFTER_DRAIN = false;
    int layer; const float* x; const float* ctx; const float* xr1_in; float* xr1_out; float* out; const float* mod; const float* bmod;
    __device__ __forceinline__ void operator()(const f32x4 (&acc)[2][2][4][2], const pg8::Unit& u, int wr, int wc, int fr, int fq) const {
        const int b = u.pm / 17, tl = u.pm % 17;
        const int rloc = wr * 64 + fr;
        const float* rs; float* os;
        if (layer == 0) {
            rs = (tl == 0) ? ctx + (size_t)(b * CTXL) * DM : x + (size_t)(b * SEQ + (tl - 1) * 256) * DM;
            os = MK_XR16 ? (float*)((bf16*)xr1_out + (size_t)(u.pm * 256) * DM) : xr1_out + (size_t)(u.pm * 256) * DM;
        } else {
            rs = MK_XR16 ? (const float*)((const bf16*)xr1_in + (size_t)(u.pm * 256) * DM) : xr1_in + (size_t)(u.pm * 256) * DM;
            os = out + (size_t)(b * SEQ + (tl - 1) * 256) * DM;
        }
        const int mr = (tl == 0) ? 2 : b;
        const float* gp = mod + (size_t)mr * MODW + 2 * DM; const float* gb = bmod + 2 * DM;
        const int col0 = u.pn * 256 + wc * 32 + 8 * fq;
        f32x4 gv[2][2];
#pragma unroll
        for (int bj = 0; bj < 2; ++bj)
#pragma unroll
            for (int n = 0; n < 2; ++n) gv[bj][n] = ldg<f32x4>(gp + col0 + bj * 128 + 4 * n) + ldg<f32x4>(gb + col0 + bj * 128 + 4 * n);
#pragma unroll
        for (int ai = 0; ai < 2; ++ai)
#pragma unroll
            for (int m = 0; m < 4; ++m) {
                const size_t ro = (size_t)(rloc + ai * 128 + m * 16) * DM + col0;
#pragma unroll
                for (int bj = 0; bj < 2; ++bj)
#pragma unroll
                    for (int n = 0; n < 2; ++n) {
                        f32x4 r;
                        if (MK_XR16 && layer != 0) { const u32x2 w = ldg<u32x2>((const bf16*)rs + ro + bj * 128 + 4 * n); r[0] = bflo(w.x); r[1] = bfhi(w.x); r[2] = bflo(w.y); r[3] = bfhi(w.y); }
                        else r = ldg<f32x4>(rs + ro + bj * 128 + 4 * n);
                        const f32x4 y = r + gv[bj][n] * acc[ai][bj][m][n];
                        if (MK_XR16 && layer == 0) { u32x2 w; w.x = cvtpk(y[0], y[1]); w.y = cvtpk(y[2], y[3]); stg<u32x2>((bf16*)os + ro + bj * 128 + 4 * n, w); }
                        else stg<f32x4>(os + ro + bj * 128 + 4 * n, y);
                    }
            }
    }
};

struct PanelOrder {
    int c, call;
    __device__ bool next(int i, pg8::Unit& u) const { if (i > 0) return false; int pm = (c >> 4) + 16 * call; u.pm = pm + 1 + (pm >= 16 ? 1 : 0); u.pn = c & 15; return true; }
    __device__ __forceinline__ void a_ready(const pg8::Unit&) const {}
    __device__ __forceinline__ void done(const pg8::Unit&) const {}
};
struct EpiOutNorm {
    static constexpr bool PERM = true, AFTER_DRAIN = true;
    const bf16* xr1_in; float* out; const float* mod; const float* bmod; const float* gfin; float* slots; unsigned* cnt;
    __device__ __forceinline__ void operator()(const f32x4 (&)[2][2][4][2], const pg8::Unit&, int, int, int, int) const {}
    __device__ __forceinline__ void fused(f32x4 (&acc)[2][2][4][2], const pg8::Unit& u, int wr, int wc, int fr, int fq, LAS unsigned char* lds, int wid, int lane) const {
        const int b = u.pm / 17, tl = u.pm % 17, tid = wid * 64 + lane;
        const int rloc = wr * 64 + fr;
        const bf16* rs = xr1_in + (size_t)(u.pm * 256) * DM; float* os = out + (size_t)(b * SEQ + (tl - 1) * 256) * DM;
        const float* gp = mod + (size_t)b * MODW + 2 * DM; const float* gb = bmod + 2 * DM;
        const int col0 = u.pn * 256 + wc * 32 + 8 * fq;
        LAS float* part = (LAS float*)lds; LAS float* rst = part + 1024;
        { f32x4 gv[2][2];
#pragma unroll
          for (int bj = 0; bj < 2; ++bj)
#pragma unroll
              for (int n = 0; n < 2; ++n) gv[bj][n] = ldg<f32x4>(gp + col0 + bj * 128 + 4 * n) + ldg<f32x4>(gb + col0 + bj * 128 + 4 * n);
#pragma unroll
          for (int ai = 0; ai < 2; ++ai)
#pragma unroll
              for (int m = 0; m < 4; ++m) {
                  const size_t ro = (size_t)(rloc + ai * 128 + m * 16) * DM + col0; float sq = 0.f;
#pragma unroll
                  for (int bj = 0; bj < 2; ++bj)
#pragma unroll
                      for (int n = 0; n < 2; ++n) {
                          const u32x2 w = ldg<u32x2>(rs + ro + bj * 128 + 4 * n); f32x4 r; r[0] = bflo(w.x); r[1] = bfhi(w.x); r[2] = bflo(w.y); r[3] = bfhi(w.y);
                          const f32x4 y = r + gv[bj][n] * acc[ai][bj][m][n]; acc[ai][bj][m][n] = y;
                          sq += (y[0] * y[0] + y[1] * y[1]) + (y[2] * y[2] + y[3] * y[3]); }
                  sq += shl_xor(sq, 16, lane); sq += shl_xor(sq, 32, lane);
                  if (fq == 0) part[(rloc + ai * 128 + m * 16) * 4 + wc] = sq; } }
        __syncthreads();
        float* slot = slots + ((size_t)u.pm * 16 + u.pn) * 256;
        if (tid < 256) stg_wt4(slot + tid, __float_as_uint((part[tid * 4] + part[tid * 4 + 1]) + (part[tid * 4 + 2] + part[tid * 4 + 3])));
        asm volatile("s_waitcnt vmcnt(0)" ::: "memory");
        __syncthreads();
        if (wid == 0) {
            if (lane == 0) __hip_atomic_fetch_add(cnt + u.pm, 1u, __ATOMIC_RELAXED, __HIP_MEMORY_SCOPE_AGENT);
            unsigned sp = 0u;
            while (__hip_atomic_load(cnt + u.pm, __ATOMIC_RELAXED, __HIP_MEMORY_SCOPE_AGENT) < 16u) { __builtin_amdgcn_s_sleep(2); if (++sp > (1u << 22)) break; }
            __builtin_amdgcn_fence(__ATOMIC_ACQUIRE, "agent"); }
        asm volatile("s_waitcnt vmcnt(0)" ::: "memory");
        __syncthreads();
        if (tid < 256) { const float* sp_ = slots + (size_t)u.pm * 16 * 256 + tid; float t = 0.f;
#pragma unroll
            for (int q = 0; q < 16; ++q) t += ldg<float>(sp_ + q * 256);
            rst[tid] = rsqrtf(t * (1.f / DM) + EPS); }
        __syncthreads();
        { f32x4 gf[2][2];
#pragma unroll
          for (int bj = 0; bj < 2; ++bj)
#pragma unroll
              for (int n = 0; n < 2; ++n) gf[bj][n] = ldg<f32x4>(gfin + col0 + bj * 128 + 4 * n);
#pragma unroll
          for (int ai = 0; ai < 2; ++ai)
#pragma unroll
              for (int m = 0; m < 4; ++m) {
                  const size_t ro = (size_t)(rloc + ai * 128 + m * 16) * DM + col0; const float rr = rst[rloc + ai * 128 + m * 16];
#pragma unroll
                  for (int bj = 0; bj < 2; ++bj)
#pragma unroll
                      for (int n = 0; n < 2; ++n) stg<f32x4>(os + ro + bj * 128 + 4 * n, acc[ai][bj][m][n] * rr * gf[bj][n]); } }
        __syncthreads();
    }
};

struct EpiOutNormL0 {
    static constexpr bool PERM = true, AFTER_DRAIN = true;
    const float* x; const float* mod0; const float* bmod0; bf16* xr1; bf16* xn; const float* mod1; const float* bmod1; const float* gn1; float* slots; unsigned* cnt;
    __device__ __forceinline__ void operator()(const f32x4 (&)[2][2][4][2], const pg8::Unit&, int, int, int, int) const {}
    __device__ __forceinline__ void fused(f32x4 (&acc)[2][2][4][2], const pg8::Unit& u, int wr, int wc, int fr, int fq, LAS unsigned char* lds, int wid, int lane) const {
        const int b = u.pm / 17, tl = u.pm % 17, tid = wid * 64 + lane;
        const int rloc = wr * 64 + fr;
        const float* rs = x + (size_t)(b * SEQ + (tl - 1) * 256) * DM;
        const float* gp = mod0 + (size_t)b * MODW + 2 * DM; const float* gb = bmod0 + 2 * DM;
        const int col0 = u.pn * 256 + wc * 32 + 8 * fq;
        LAS float* part = (LAS float*)lds; LAS float* rst = part + 1024;
        { f32x4 gv[2][2];
#pragma unroll
          for (int bj = 0; bj < 2; ++bj)
#pragma unroll
              for (int n = 0; n < 2; ++n) gv[bj][n] = ldg<f32x4>(gp + col0 + bj * 128 + 4 * n) + ldg<f32x4>(gb + col0 + bj * 128 + 4 * n);
#pragma unroll
          for (int ai = 0; ai < 2; ++ai)
#pragma unroll
              for (int m = 0; m < 4; ++m) {
                  const size_t ro = (size_t)(rloc + ai * 128 + m * 16) * DM + col0; float sq = 0.f;
#pragma unroll
                  for (int bj = 0; bj < 2; ++bj)
#pragma unroll
                      for (int n = 0; n < 2; ++n) {
                          const f32x4 y = ldg<f32x4>(rs + ro + bj * 128 + 4 * n) + gv[bj][n] * acc[ai][bj][m][n]; acc[ai][bj][m][n] = y;
                          sq += (y[0] * y[0] + y[1] * y[1]) + (y[2] * y[2] + y[3] * y[3]);
                          u32x2 w; w.x = cvtpk(y[0], y[1]); w.y = cvtpk(y[2], y[3]); stg<u32x2>(xr1 + (size_t)(u.pm * 256) * DM + ro + bj * 128 + 4 * n, w); }
                  sq += shl_xor(sq, 16, lane); sq += shl_xor(sq, 32, lane);
                  if (fq == 0) part[(rloc + ai * 128 + m * 16) * 4 + wc] = sq; } }
        __syncthreads();
        float* slot = slots + ((size_t)u.pm * 16 + u.pn) * 256;
        if (tid < 256) stg_wt4(slot + tid, __float_as_uint((part[tid * 4] + part[tid * 4 + 1]) + (part[tid * 4 + 2] + part[tid * 4 + 3])));
        asm volatile("s_waitcnt vmcnt(0)" ::: "memory");
        __syncthreads();
        if (wid == 0) {
            if (lane == 0) __hip_atomic_fetch_add(cnt + u.pm, 1u, __ATOMIC_RELAXED, __HIP_MEMORY_SCOPE_AGENT);
            unsigned sp = 0u;
            while (__hip_atomic_load(cnt + u.pm, __ATOMIC_RELAXED, __HIP_MEMORY_SCOPE_AGENT) < 16u) { __builtin_amdgcn_s_sleep(2); if (++sp > (1u << 22)) break; }
            __builtin_amdgcn_fence(__ATOMIC_ACQUIRE, "agent"); }
        asm volatile("s_waitcnt vmcnt(0)" ::: "memory");
        __syncthreads();
        if (tid < 256) { const float* sp_ = slots + (size_t)u.pm * 16 * 256 + tid; float t = 0.f;
#pragma unroll
            for (int q = 0; q < 16; ++q) t += ldg<float>(sp_ + q * 256);
            rst[tid] = rsqrtf(t * (1.f / DM) + EPS); }
        __syncthreads();
        { const float* mp = mod1 + (size_t)b * MODW;
          f32x4 A[2][2], B[2][2];
#pragma unroll
          for (int bj = 0; bj < 2; ++bj)
#pragma unroll
              for (int n = 0; n < 2; ++n) { const int k = col0 + bj * 128 + 4 * n;
                  A[bj][n] = ldg<f32x4>(gn1 + k) * (ldg<f32x4>(mp + DM + k) + ldg<f32x4>(bmod1 + DM + k) + 1.0f); B[bj][n] = ldg<f32x4>(mp + k) + ldg<f32x4>(bmod1 + k); }
#pragma unroll
          for (int ai = 0; ai < 2; ++ai)
#pragma unroll
              for (int m = 0; m < 4; ++m) {
                  const size_t ro = (size_t)(u.pm * 256 + rloc + ai * 128 + m * 16) * DM + col0; const float rr = rst[rloc + ai * 128 + m * 16];
#pragma unroll
                  for (int bj = 0; bj < 2; ++bj)
#pragma unroll
                      for (int n = 0; n < 2; ++n) { const f32x4 h = acc[ai][bj][m][n] * rr * A[bj][n] + B[bj][n];
                          u32x2 w; w.x = cvtpk(h[0], h[1]); w.y = cvtpk(h[2], h[3]); stg<u32x2>(xn + ro + bj * 128 + 4 * n, w); } } }
        __syncthreads();
    }
};

struct KSplitOrder {
    int c;
    __device__ bool next(int i, pg8::Unit& u) const { if (i > 0) return false; const int unit = c >> 3; u.pm = (unit >> 4) * 17; u.pn = unit & 15; return true; }
    __device__ __forceinline__ void a_ready(const pg8::Unit&) const {}
    __device__ __forceinline__ void done(const pg8::Unit&) const {}
};
struct EpiPart {
    static constexpr bool PERM = true, AFTER_DRAIN = false;
    float* part; int ks;
    __device__ __forceinline__ void operator()(const f32x4 (&acc)[2][2][4][2], const pg8::Unit& u, int wr, int wc, int fr, int fq) const {
        float* os = part + ((size_t)ks * (NBATCH * CTXL) + (size_t)(u.pm / 17) * CTXL) * DM;
        const int col0 = u.pn * 256 + wc * 32 + 8 * fq, rloc = wr * 64 + fr;
#pragma unroll
        for (int ai = 0; ai < 2; ++ai)
#pragma unroll
            for (int m = 0; m < 4; ++m) { float* rp = os + (size_t)(rloc + ai * 128 + m * 16) * DM + col0;
#pragma unroll
                for (int bj = 0; bj < 2; ++bj)
#pragma unroll
                    for (int n = 0; n < 2; ++n) stg<f32x4>(rp + bj * 128 + 4 * n, acc[ai][bj][m][n]); }
    }
};

namespace att {
constexpr int D = 128, NW = 8, QBLK = 32, KVBLK = 64;
constexpr float SCALE = 0.088388347648318440f;
constexpr float THR = 8.f;
constexpr int LDQ = AQW, LDK = AKW;
constexpr size_t SHM_V = KVBLK * D * 2, SHM_K = KVBLK * D * 2, SHM_ATTN = 2 * SHM_V + 2 * SHM_K + NW * 64 * 4;
#define KSWZ(row, colB) ((row) * 256 + ((colB) ^ (((row) & 7) << 4)))
#define SBAR() __builtin_amdgcn_sched_barrier(0)
__device__ __forceinline__ int crow(int r, int hi) { return (r & 3) + 8 * (r >> 2) + 4 * hi; }
__device__ __forceinline__ unsigned cvtpkv(float lo, float hi) { unsigned r; asm volatile("v_cvt_pk_bf16_f32 %0, %1, %2" : "=v"(r) : "v"(lo), "v"(hi)); return r; }
template <bool FIXM> __device__ __forceinline__ void partialSM(f32x16& p0, f32x16& p1, float& m_reg, float& mn, float& alpha) {
  constexpr float C = SCALE * 1.4426950408889634f;
  if constexpr (FIXM) {
    mn = m_reg; alpha = 1.f; const float mnC0 = -m_reg * C;
#pragma unroll
    for (int r = 0; r < 16; ++r) p0[r] = fmaf(p0[r], C, mnC0);
#pragma unroll
    for (int r = 0; r < 16; ++r) p1[r] = fmaf(p1[r], C, mnC0);
#pragma unroll
    for (int r = 0; r < 16; ++r) p0[r] = __builtin_amdgcn_exp2f(p0[r]);
    return;
  }
  float pmax = p0[0];
#pragma unroll
  for (int r = 1; r < 16; ++r) pmax = fmaxf(pmax, p0[r]);
#pragma unroll
  for (int r = 0; r < 16; ++r) pmax = fmaxf(pmax, p1[r]);
  { auto rr = __builtin_amdgcn_permlane32_swap(__float_as_uint(pmax), __float_as_uint(pmax), false, false);
    pmax = fmaxf(__uint_as_float(rr[0]), __uint_as_float(rr[1])); }
  if (__builtin_expect(__all(pmax - m_reg <= THR / SCALE), 1)) { mn = m_reg; alpha = 1.f; }
  else { mn = fmaxf(m_reg, pmax); alpha = __builtin_amdgcn_exp2f((m_reg - mn) * C); m_reg = mn; }
  float mnC = -mn * C;
#pragma unroll
  for (int r = 0; r < 16; ++r) p0[r] = fmaf(p0[r], C, mnC);
#pragma unroll
  for (int r = 0; r < 16; ++r) p1[r] = fmaf(p1[r], C, mnC);
#pragma unroll
  for (int r = 0; r < 16; ++r) p0[r] = __builtin_amdgcn_exp2f(p0[r]);
}
__device__ __forceinline__ void finishSM(f32x16& p0, f32x16& p1, float alpha, float& l_reg, bf16x8& pa0, bf16x8& pa1, bf16x8& pa2, bf16x8& pa3) {
#pragma unroll
  for (int r = 0; r < 16; ++r) p1[r] = __builtin_amdgcn_exp2f(p1[r]);
  float ps = 0;
#pragma unroll
  for (int r = 0; r < 16; ++r) ps += p0[r];
#pragma unroll
  for (int r = 0; r < 16; ++r) ps += p1[r];
  { auto rr = __builtin_amdgcn_permlane32_swap(__float_as_uint(ps), __float_as_uint(ps), false, false);
    ps = __uint_as_float(rr[0]) + __uint_as_float(rr[1]); }
  l_reg = l_reg * alpha + ps;
#define PK4(P, BASE, OUT) do { unsigned a0 = cvtpkv(P[BASE + 0], P[BASE + 1]), a1 = cvtpkv(P[BASE + 2], P[BASE + 3]);   \
    unsigned b0 = cvtpkv(P[BASE + 4], P[BASE + 5]), b1 = cvtpkv(P[BASE + 6], P[BASE + 7]);                              \
    auto r0 = __builtin_amdgcn_permlane32_swap(a0, b0, false, false); auto r1 = __builtin_amdgcn_permlane32_swap(a1, b1, false, false); \
    u32x4 w = {r0[0], r1[0], r0[1], r1[1]}; OUT = *reinterpret_cast<bf16x8*>(&w); } while (0)
  PK4(p0, 0, pa0); PK4(p0, 8, pa1); PK4(p1, 0, pa2); PK4(p1, 8, pa3);
#undef PK4
}
__device__ __forceinline__ void qkt(f32x16& p0, f32x16& p1, const bf16* Ks, const bf16x8* qr, int r32, int hi) {
  p0 = f32x16{}; p1 = f32x16{};
#pragma unroll
  for (int d0 = 0; d0 < 8; ++d0) { int cb = (d0 * 16 + hi * 8) * 2;
    bf16x8 b0 = *reinterpret_cast<const bf16x8*>((const char*)Ks + KSWZ(r32, cb));
    bf16x8 b1 = *reinterpret_cast<const bf16x8*>((const char*)Ks + KSWZ(32 + r32, cb));
    p0 = __builtin_amdgcn_mfma_f32_32x32x16_bf16(b0, qr[d0], p0, 0, 0, 0);
    p1 = __builtin_amdgcn_mfma_f32_32x32x16_bf16(b1, qr[d0], p1, 0, 0, 0); }
}
__device__ __forceinline__ int v_st(int k, int c) { const int kk = (k & ~0xC) | ((k & 4) << 1) | ((k & 8) >> 1); return ((kk >> 3) * 4 + (c >> 5)) * 512 + ((kk & 7) * 32 + (c & 31)) * 2; }
__device__ __forceinline__ int v_rd_base(int lane) { return ((lane & 3) << 3) | (((lane >> 2) & 3) << 6) | (((lane >> 4) & 1) << 5) | (((lane >> 5) & 1) << 8); }
constexpr int v_rd_off(int d0, int ks, int half) { return d0 * 512 + ks * 4096 + half * 2048; }
template <int OFF> __device__ __forceinline__ s16x4 tr_read(int vb) {
  s16x4 r; asm volatile("ds_read_b64_tr_b16 %0, %1 offset:%2" : "=&v"(r) : "v"(vb), "i"(OFF) : "memory"); return r;
}
template <int D0> __device__ __forceinline__ void pv_one(f32x16& od, int vb, bf16x8 pa0, bf16x8 pa1, bf16x8 pa2, bf16x8 pa3) {
  const s16x4 l0 = tr_read<v_rd_off(D0, 0, 0)>(vb), h0 = tr_read<v_rd_off(D0, 0, 1)>(vb), l1 = tr_read<v_rd_off(D0, 1, 0)>(vb), h1 = tr_read<v_rd_off(D0, 1, 1)>(vb);
  const s16x4 l2 = tr_read<v_rd_off(D0, 2, 0)>(vb), h2 = tr_read<v_rd_off(D0, 2, 1)>(vb), l3 = tr_read<v_rd_off(D0, 3, 0)>(vb), h3 = tr_read<v_rd_off(D0, 3, 1)>(vb);
  asm volatile("s_waitcnt lgkmcnt(0)" ::: "memory"); SBAR();
#define PKV(L, H) (bf16x8){L[0], L[1], L[2], L[3], H[0], H[1], H[2], H[3]}
  od = __builtin_amdgcn_mfma_f32_32x32x16_bf16(pa0, PKV(l0, h0), od, 0, 0, 0);
  od = __builtin_amdgcn_mfma_f32_32x32x16_bf16(pa1, PKV(l1, h1), od, 0, 0, 0);
  od = __builtin_amdgcn_mfma_f32_32x32x16_bf16(pa2, PKV(l2, h2), od, 0, 0, 0);
  od = __builtin_amdgcn_mfma_f32_32x32x16_bf16(pa3, PKV(l3, h3), od, 0, 0, 0);
#undef PKV
}
__device__ __forceinline__ void pv_d0(f32x16* o, int vb, bf16x8 pa0, bf16x8 pa1, bf16x8 pa2, bf16x8 pa3) {
  pv_one<0>(o[0], vb, pa0, pa1, pa2, pa3); pv_one<1>(o[1], vb, pa0, pa1, pa2, pa3); pv_one<2>(o[2], vb, pa0, pa1, pa2, pa3); pv_one<3>(o[3], vb, pa0, pa1, pa2, pa3);
}
template <bool FIXM> __device__ __forceinline__ void attn_dense_body(const bf16* __restrict__ Qb, const bf16* __restrict__ Kh, const bf16* __restrict__ Vh,
                                                const bf16* __restrict__ Zb, bf16* __restrict__ Yb, int seq, char* lds, const int tid,
                                                float* part, unsigned* ticket, int pidx, volatile LAS unsigned* bcast, const float mfix, const bool skip_epi = false) {
  const int wid = tid >> 6, lane = tid & 63, r32 = lane & 31, hi = lane >> 5;
  bf16* V_lds = (bf16*)lds; bf16* K_lds = (bf16*)(lds + 2 * SHM_V);
  float* ws = (float*)(lds + 2 * SHM_V + 2 * SHM_K) + wid * 64; float* li_l = ws; float* al_l = ws + 32;
  float m_reg = FIXM ? mfix : -1e30f, l_reg = 0; f32x16 o[4] = {}; bf16x8 qr[8];
  const bf16* Qw = Qb + (long)(wid * QBLK + r32) * LDQ + hi * 8;
#pragma unroll
  for (int d0 = 0; d0 < 8; ++d0) qr[d0] = ldg<bf16x8>(Qw + d0 * 16);
  const int sr = tid >> 4, sc = (tid & 15) * 8, vst0 = v_st(sr, sc), vst1 = v_st(32 + sr, sc);
  const int vb0 = (int)(uintptr_t)V_lds + v_rd_base(lane);
  struct { bf16x8 vs0, vs1, ks0, ks1; } sr_[2];
#define SLOAD(i, k0) do { sr_[i].vs0 = ldg<bf16x8>(&Vh[(long)((k0) + sr) * LDK + sc]); sr_[i].vs1 = ldg<bf16x8>(&Vh[(long)((k0) + 32 + sr) * LDK + sc]); \
    sr_[i].ks0 = ldg<bf16x8>(&Kh[(long)((k0) + sr) * LDK + sc]); sr_[i].ks1 = ldg<bf16x8>(&Kh[(long)((k0) + 32 + sr) * LDK + sc]); } while (0)
#define SWRITE(b, i) do { *(bf16x8*)((char*)V_lds + (b) * SHM_V + vst0) = sr_[i].vs0;          \
    *(bf16x8*)((char*)V_lds + (b) * SHM_V + vst1) = sr_[i].vs1; int kc = sc * 2;               \
    *(bf16x8*)((char*)K_lds + (b) * SHM_K + KSWZ(sr, kc)) = sr_[i].ks0;                       \
    *(bf16x8*)((char*)K_lds + (b) * SHM_K + KSWZ(32 + sr, kc)) = sr_[i].ks1; } while (0)
#define SWAIT() asm volatile("s_waitcnt vmcnt(4)" ::: "memory")
#define RESC(a) do { if (!FIXM && __any((a) < 1.f)) { if (hi == 0) al_l[r32] = (a); asm volatile("s_waitcnt lgkmcnt(0)" ::: "memory"); \
    _Pragma("unroll") for (int d = 0; d < 4; ++d) _Pragma("unroll") for (int r = 0; r < 16; ++r) o[d][r] *= al_l[crow(r, hi)]; } } while (0)
  f32x16 pA0, pA1, pB0, pB1; float mnA, mnB, alA, alB; bf16x8 pa0, pa1, pa2, pa3; const int NT = seq / KVBLK;
  constexpr int SE = 0, SO = 1;
  SLOAD(SE, 0); asm volatile("s_waitcnt vmcnt(0)" ::: "memory"); SWRITE(0, SE); __syncthreads();
  qkt(pA0, pA1, K_lds, qr, r32, hi); partialSM<FIXM>(pA0, pA1, m_reg, mnA, alA);
  SLOAD(SO, KVBLK); if (2 < NT) SLOAD(SE, 2 * KVBLK);
  SWAIT(); SWRITE(1, SO); __syncthreads();
  for (int j = 1; j + 1 < NT; j += 2) {
    SBAR(); qkt(pB0, pB1, (bf16*)((char*)K_lds + SHM_K), qr, r32, hi);
    finishSM(pA0, pA1, alA, l_reg, pa0, pa1, pa2, pa3); SBAR();
    SLOAD(SO, (j + 2) * KVBLK); SBAR();
    pv_d0(o, vb0, pa0, pa1, pa2, pa3); partialSM<FIXM>(pB0, pB1, m_reg, mnB, alB);
    __syncthreads(); SWAIT(); SWRITE(0, SE);
    RESC(alB); __syncthreads();
    SBAR(); qkt(pA0, pA1, K_lds, qr, r32, hi);
    finishSM(pB0, pB1, alB, l_reg, pa0, pa1, pa2, pa3); SBAR();
    if (j + 3 < NT) SLOAD(SE, (j + 3) * KVBLK); SBAR();
    pv_d0(o, vb0 + (int)SHM_V, pa0, pa1, pa2, pa3); partialSM<FIXM>(pA0, pA1, m_reg, mnA, alA);
    __syncthreads(); SWAIT(); SWRITE(1, SO);
    RESC(alA); __syncthreads();
  }
  SBAR(); qkt(pB0, pB1, (bf16*)((char*)K_lds + SHM_K), qr, r32, hi);
  finishSM(pA0, pA1, alA, l_reg, pa0, pa1, pa2, pa3); SBAR();
  pv_d0(o, vb0, pa0, pa1, pa2, pa3); partialSM<FIXM>(pB0, pB1, m_reg, mnB, alB);
  __syncthreads(); RESC(alB);
  finishSM(pB0, pB1, alB, l_reg, pa0, pa1, pa2, pa3); SBAR();
  pv_d0(o, vb0 + (int)SHM_V, pa0, pa1, pa2, pa3);
  if (part != nullptr) {
    constexpr float C = SCALE * 1.4426950408889634f;
    float* mine = part + (size_t)pidx * (66 * 512) + tid;
    asm volatile("" : "+v"(mine) :: "memory"); SBAR();
#pragma unroll
    for (int d0 = 0; d0 < 4; ++d0)
#pragma unroll
      for (int r = 0; r < 16; ++r) stg_wt4(mine + (d0 * 16 + r) * 512, __float_as_uint(o[d0][r]));
    stg_wt4(mine + 64 * 512, __float_as_uint(m_reg)); stg_wt4(mine + 65 * 512, __float_as_uint(l_reg));
    asm volatile("s_waitcnt vmcnt(0)" ::: "memory");
    __syncthreads();
    if (tid == 0) bcast[0] = __hip_atomic_fetch_add(ticket, 1u, __ATOMIC_RELAXED, __HIP_MEMORY_SCOPE_AGENT);
    __syncthreads();
    const unsigned tk = bcast[0];
    __syncthreads();
    if (tk != (unsigned)(NPART - 1)) return;
    if (wid == 0) __builtin_amdgcn_fence(__ATOMIC_ACQUIRE, "agent");
    asm volatile("s_waitcnt vmcnt(0)" ::: "memory");
    __syncthreads();
#pragma unroll 1
    for (int sft = 1; sft < NPART; ++sft) {
      const float* other = part + (size_t)((pidx + sft) & (NPART - 1)) * (66 * 512) + tid;
      asm volatile("" : "+v"(other) :: "memory");
      const float m2 = ldg<float>(other + 64 * 512), l2 = ldg<float>(other + 65 * 512);
      const float mm = fmaxf(m_reg, m2), a1 = __builtin_amdgcn_exp2f((m_reg - mm) * C), a2 = __builtin_amdgcn_exp2f((m2 - mm) * C);
      l_reg = l_reg * a1 + l2 * a2; m_reg = mm;
      if (hi == 0) { li_l[r32] = a1; al_l[r32] = a2; } asm volatile("s_waitcnt lgkmcnt(0)" ::: "memory");
#pragma unroll
      for (int r = 0; r < 16; ++r) { const float f1 = li_l[crow(r, hi)], f2 = al_l[crow(r, hi)];
#pragma unroll
        for (int d0 = 0; d0 < 4; ++d0) o[d0][r] = o[d0][r] * f1 + ldg<float>(other + (d0 * 16 + r) * 512) * f2;
        if ((r & 3) == 3) { asm volatile("" ::: "memory"); SBAR(); } }
      asm volatile("s_waitcnt lgkmcnt(0)" ::: "memory"); SBAR();
    }
  }
  if (hi == 0) li_l[r32] = l_reg; asm volatile("s_waitcnt lgkmcnt(0)" ::: "memory");
  float rli[16];
#pragma unroll
  for (int r = 0; r < 16; ++r) rli[r] = __builtin_amdgcn_rcpf(li_l[crow(r, hi)]);
  bf16* Yl = Yb + (long)(wid * QBLK + 4 * hi) * DM + r32; const bf16* Zl = Zb + (long)(wid * QBLK + 4 * hi) * AQW + r32;
  asm volatile("" : "+v"(Yl), "+v"(Zl) :: "memory"); SBAR();
#if MK_PER_PHASE
  if (skip_epi) return;
#endif
#if MK_EPILDS
  (void)Yl; (void)Zl;
  { float* ep = (float*)(lds + SHM_ATTN) + wid * 2048;
    const int erow = lane >> 4, epc = lane & 15;
    const bf16* Ze = Zb + (long)(wid * QBLK + erow) * AQW + 4 * epc; bf16* Ye = Yb + (long)(wid * QBLK + erow) * DM + 4 * epc;
    asm volatile("" : "+v"(Ze), "+v"(Ye) :: "memory");
#pragma unroll
    for (int ps = 0; ps < 2; ++ps) {
#pragma unroll
      for (int r = 0; r < 16; ++r)
#pragma unroll
        for (int dd = 0; dd < 2; ++dd) ep[crow(r, hi) * 64 + dd * 32 + r32] = o[2 * ps + dd][r] * rli[r];
      asm volatile("s_waitcnt lgkmcnt(0)" ::: "memory"); SBAR();
#pragma unroll
      for (int i = 0; i < 8; ++i) {
        const f32x4 v = *(const f32x4*)(ep + (erow + 4 * i) * 64 + 4 * epc);
        const u32x2 zz = ldg<u32x2>(Ze + (long)(4 * i) * AQW + 64 * ps);
        u32x2 w; w.x = cvtpk(v[0] * bflo(zz.x), v[1] * bfhi(zz.x)); w.y = cvtpk(v[2] * bflo(zz.y), v[3] * bfhi(zz.y));
        stg<u32x2>(Ye + (long)(4 * i) * DM + 64 * ps, w); }
      asm volatile("s_waitcnt lgkmcnt(0)" ::: "memory"); SBAR();
    } }
#else
#pragma unroll
  for (int r = 0; r < 16; ++r) { const int rr = (r & 3) + 8 * (r >> 2);
#pragma unroll
    for (int d0 = 0; d0 < 4; ++d0) { const float z = bf2f(ldg<bf16>(Zl + rr * AQW + d0 * 32)); stg<bf16>(Yl + rr * DM + d0 * 32, f2bf(o[d0][r] * rli[r] * z)); }
    if ((r & 3) == 3) { asm volatile("" ::: "memory"); SBAR(); } }
#endif
#undef SLOAD
#undef SWRITE
#undef SWAIT
#undef RESC
}
}

__device__ __forceinline__ int pperm(int d) { return d < 32 ? 2 * d : d < 64 ? 2 * (d - 32) + 1 : d < 96 ? 2 * (d - 32) : 2 * (d - 64) + 1; }
__device__ __forceinline__ int win_dest_row(int c) {
    if (c < SC_MO) return c;
    if (c < SC_MZ) { const int r = c - SC_MO; return DN_OZ + (r >> 7) * 256 + (r & 127); }
    if (c < SC_G)  { const int r = c - SC_MZ; return DN_OZ + (r >> 7) * 256 + 128 + (r & 127); }
    if (c < SC_AK) { const int r = c - SC_AQ; return DN_AQ + (r & ~127) + pperm(r & 127); }
    if (c < SC_AV) { const int r = c - SC_AK; return DN_AK + (r & ~127) + pperm(r & 127); }
    if (c < SC_AZ) return DN_AV + (c - SC_AV);
    return DN_AZ + (c - SC_AZ);
}
template <bool WIN> __device__ __forceinline__ void tr_item(const float* __restrict__ W, int ldw, bf16* __restrict__ WT, int k0, int c0, LAS float* scr, int lane) {
    const int kr = lane >> 4, cq = lane & 15;
    f32x4 v[16];
    const float* wp = W + (size_t)(k0 + kr) * ldw + c0 + 4 * cq;
#pragma unroll
    for (int i = 0; i < 16; ++i) v[i] = ldg<f32x4>(wp + (size_t)(4 * i) * ldw);
#pragma unroll
    for (int i = 0; i < 16; ++i) { LAS float* s = scr + (4 * i + kr) * 65 + 4 * cq; s[0] = v[i][0]; s[1] = v[i][1]; s[2] = v[i][2]; s[3] = v[i][3]; }
    LDS_WAIT();
    const int c = lane & 7;
#pragma unroll
    for (int j = 0; j < 8; ++j) {
        const int sl = (lane >> 3) + 8 * j; const LAS float* s = scr + (8 * c) * 65 + sl;
        u32x4 o; o.x = cvtpk(s[0 * 65], s[1 * 65]); o.y = cvtpk(s[2 * 65], s[3 * 65]); o.z = cvtpk(s[4 * 65], s[5 * 65]); o.w = cvtpk(s[6 * 65], s[7 * 65]);
        const int n = WIN ? win_dest_row(c0 + sl) : (c0 + sl);
        stg<u32x4>(WT + (size_t)n * DM + k0 + 8 * c, o);
    }
    LDS_WAIT();
}

struct Ptrs {
    const float *x, *c, *ctx, *c_ctx, *w_mod, *b_mod, *g_norm, *w_in, *b_gate, *g_mlstm, *g_q, *g_k, *w_out, *g_final;
    float* out; unsigned char* ws;
};

__device__ __forceinline__ void p0_prologue(const Ptrs& P, LAS unsigned char* lds, int gw, int NGW, int wave, int lane, const bool skip_wout, const bool skip_win1) {
    LAS float* scr = (LAS float*)(lds + wave * 16640);
    bf16* WinT = (bf16*)(P.ws + WS_WINT); bf16* WoutT = (bf16*)(P.ws + WS_WOUTT);
    constexpr int I_IN = 64 * 208, I_OUT = 64 * 64, I_L = I_IN + I_OUT;
    for (int it = gw; it < 2 * I_L; it += NGW) {
        const int l = it / I_L; int r = it % I_L;
        if (r < I_IN) { if (skip_win1 && l == 1) continue;
            const int kb = r / 208, cb = r % 208; const int c0 = cb < 128 ? 64 * cb : SC_AQ + 64 * (cb - 128);
            tr_item<true>(P.w_in + (size_t)l * DM * IN_COLS, IN_COLS, WinT + (size_t)l * NIN * DM, 64 * kb, c0, scr, lane); }
        else if (!skip_wout) { r -= I_IN; const int kb = r / 64, cb = r % 64;
            tr_item<false>(P.w_out + (size_t)l * DM * DM, DM, WoutT + (size_t)l * DM * DM, 64 * kb, 64 * cb, scr, lane); }
    }
    { bf16* WgT = (bf16*)(P.ws + WS_WGT);
      for (int idx = gw * 64 + lane; idx < 2 * 16 * DM; idx += NGW * 64) { const int l = idx >> 16, k = (idx >> 4) & (DM - 1), j = idx & 15;
          stg<bf16>(WgT + ((size_t)l * 16 + j) * DM + k, f2bf(ldg<float>(P.w_in + ((size_t)l * DM + k) * IN_COLS + SC_G + j))); } }
    if (gw == 0) { float* tab = (float*)(P.ws + WS_ROPE);
        for (int idx = lane; idx < 2048; idx += 64) { const int pos = idx >> 5, i = idx & 31; const float inv = powf(10000.0f, -(float)(2 * i) / 64.0f); const float a = (float)pos * inv;
            stg<float>(tab + idx, cosf(a)); stg<float>(tab + 2048 + idx, sinf(a)); } }
}

__device__ __forceinline__ void p0_wout_items(const Ptrs& P, LAS unsigned char* lds, int layer, int wv, int nwv, int wave, int lane) {
    LAS float* scr = (LAS float*)(lds + wave * 16640);
    bf16* WoutT = (bf16*)(P.ws + WS_WOUTT);
    for (int r = wv; r < 64 * 64; r += nwv) { const int kb = r / 64, cb = r % 64;
        tr_item<false>(P.w_out + (size_t)layer * DM * DM, DM, WoutT + (size_t)layer * DM * DM, 64 * kb, 64 * cb, scr, lane); }
}

__device__ __forceinline__ void p0_win1_items(const Ptrs& P, LAS unsigned char* lds, int gw, int NGW, int wave, int lane) {
    LAS float* scr = (LAS float*)(lds + wave * 16640);
    bf16* WinT = (bf16*)(P.ws + WS_WINT);
    for (int r = gw; r < 64 * 208; r += NGW) { const int kb = r / 208, cb = r % 208; const int c0 = cb < 128 ? 64 * cb : SC_AQ + 64 * (cb - 128);
        tr_item<true>(P.w_in + (size_t)DM * IN_COLS, IN_COLS, WinT + (size_t)NIN * DM, 64 * kb, c0, scr, lane); }
}

__device__ __forceinline__ void p0_mod(const Ptrs& P, int gw, int NGW, int lane) {
    { float* mod = (float*)(P.ws + WS_CTL + CTL_MOD_OFF);
      for (int it = gw; it < 2 * 64 * 48; it += NGW) {
          const int l = it / 3072, r = it % 3072, kb = r / 48, nb = r % 48, k0 = kb * 64, n0 = nb * 256 + 4 * lane;
          const float c0 = ldg<float>(P.c + k0 + lane), c1 = ldg<float>(P.c + DM + k0 + lane), c2 = ldg<float>(P.c_ctx + k0 + lane);
          const float s0 = c0 * (1.f / (1.f + __expf(-c0))), s1 = c1 * (1.f / (1.f + __expf(-c1))), s2 = c2 * (1.f / (1.f + __expf(-c2)));
          f32x4 a0 = {0.f, 0.f, 0.f, 0.f}, a1 = a0, a2 = a0;
          const float* wp = P.w_mod + ((size_t)l * DM + k0) * MODW + n0;
#pragma unroll 16
          for (int kk = 0; kk < 64; ++kk) { const f32x4 w4 = ldg<f32x4>(wp + (size_t)kk * MODW);
              a0 += w4 * shl_idx(s0, kk); a1 += w4 * shl_idx(s1, kk); a2 += w4 * shl_idx(s2, kk); }
          float* mp = mod + (size_t)l * 3 * MODW + n0;
#pragma unroll
          for (int e = 0; e < 4; ++e) { atomicAdd(mp + e, a0[e]); atomicAdd(mp + MODW + e, a1[e]); atomicAdd(mp + 2 * MODW + e, a2[e]); }
      } }
}

__device__ __forceinline__ void p1_norm(const Ptrs& P, int layer, int gw, int NGW, int lane_in, bool ksplit_prev, LAS unsigned char* lds, int tid) {
    bf16* XN = (bf16*)(P.ws + WS_XN); const float* XR1 = (const float*)(P.ws + WS_XR1);
    const float* mod = (const float*)(P.ws + WS_CTL + CTL_MOD_OFF) + (size_t)layer * 3 * MODW; const float* bm = P.b_mod + (size_t)layer * MODW; const float* gn = P.g_norm + (size_t)layer * DM;
    { LAS f32x4* T = (LAS f32x4*)lds;
#pragma unroll
      for (int q = 0; q < 6; ++q) { const int e = tid + 512 * q, m = e >> 10, k = 4 * (e & 1023); const float* mpm = mod + (size_t)m * MODW;
          const f32x4 g4 = ldg<f32x4>(gn + k), sh = ldg<f32x4>(mpm + k) + ldg<f32x4>(bm + k), sc = ldg<f32x4>(mpm + DM + k) + ldg<f32x4>(bm + DM + k);
          T[(2 * m) * 1024 + (e & 1023)] = g4 * (sc + 1.0f); T[(2 * m + 1) * 1024 + (e & 1023)] = sh; }
      __syncthreads(); }
    const bool special = layer == 1 && ksplit_prev && NGW > 1024;
    const bool heavy = special && gw < 512;
    const int it0 = !special ? gw : (heavy ? gw : gw - 512), stride = !special ? NGW : (heavy ? MROWS : NGW - 512), lim = !special ? MROWS : (heavy ? 512 : NBATCH * SEQ);
    for (int it = it0; it < lim; it += stride) {
        int lane = lane_in; asm volatile("" : "+v"(lane));
        const int R = !special ? it : (heavy ? (it >> 8) * TT + (it & 255) : (it >> 12) * TT + CTXL + (it & (SEQ - 1)));
        const int b = R / TT, tau = R % TT;
        const bool redu = layer == 1 && tau < CTXL && ksplit_prev;
        const float* src = (layer == 0 || redu) ? (tau < CTXL ? P.ctx + (size_t)(b * CTXL + tau) * DM : P.x + (size_t)(b * SEQ + tau - CTXL) * DM) : XR1 + (size_t)R * DM;
        const LAS f32x4* Tm = (const LAS f32x4*)lds + (tau < CTXL ? 2 : b) * 2048 + lane;
        f32x4 v[16]; float s = 0.f;
        if (MK_XR16 && !(layer == 0 || redu)) {
            const bf16* s16 = (const bf16*)XR1 + (size_t)R * DM + 4 * lane;
#pragma unroll
            for (int j = 0; j < 16; ++j) { const u32x2 w = ldg<u32x2>(s16 + 256 * j); v[j][0] = bflo(w.x); v[j][1] = bfhi(w.x); v[j][2] = bflo(w.y); v[j][3] = bfhi(w.y); }
        } else {
#pragma unroll
            for (int j = 0; j < 16; ++j) v[j] = ldg<f32x4>(src + 4 * lane + 256 * j);
        }
        if (redu) { const float* pp = (const float*)(P.ws + WS_PART) + (size_t)(b * CTXL + tau) * DM + 4 * lane;
            const float* g0 = (const float*)(P.ws + WS_CTL + CTL_MOD_OFF) + (size_t)2 * MODW + 2 * DM + 4 * lane; const float* gb0 = P.b_mod + 2 * DM + 4 * lane;
#pragma unroll
            for (int j = 0; j < 16; ++j) { f32x4 a = ldg<f32x4>(pp + 256 * j);
#pragma unroll
                for (int ks = 1; ks < 8; ++ks) a += ldg<f32x4>(pp + (size_t)ks * (NBATCH * CTXL) * DM + 256 * j);
                v[j] += (ldg<f32x4>(g0 + 256 * j) + ldg<f32x4>(gb0 + 256 * j)) * a;
                if (j & 1) { asm volatile("" ::: "memory"); __builtin_amdgcn_sched_barrier(0); } } }
#pragma unroll
        for (int j = 0; j < 16; ++j) s += (v[j][0] * v[j][0] + v[j][1] * v[j][1]) + (v[j][2] * v[j][2] + v[j][3] * v[j][3]);
        const float rstd = rsqrtf(wave_sum(s, lane) * (1.f / DM) + EPS);
        bf16* o = XN + (size_t)R * DM + 4 * lane;
#pragma unroll
        for (int j = 0; j < 16; ++j) {
            const f32x4 h = v[j] * rstd * Tm[64 * j] + Tm[1024 + 64 * j];
            u32x2 w; w.x = cvtpk(h[0], h[1]); w.y = cvtpk(h[2], h[3]); stg<u32x2>(o + 256 * j, w);
            if ((j & 3) == 3) { asm volatile("" ::: "memory"); __builtin_amdgcn_sched_barrier(0); } }
    }
}

__device__ __forceinline__ void p1_ctx_coop(const Ptrs& P, LAS unsigned char* lds, int bid, int wave, int lane) {
    const int cr = 2 * bid + (wave >> 2), q = wave & 3, b = cr >> 8, tau = cr & 255;
    const size_t ro = (size_t)(b * CTXL + tau) * DM + 1024 * q + 4 * lane;
    const float* src = P.ctx + ro; const float* pp = (const float*)(P.ws + WS_PART) + ro;
    const float* g0 = (const float*)(P.ws + WS_CTL + CTL_MOD_OFF) + (size_t)2 * MODW + 2 * DM + 1024 * q + 4 * lane; const float* gb0 = P.b_mod + 2 * DM + 1024 * q + 4 * lane;
    f32x4 v[4]; float s = 0.f;
#pragma unroll
    for (int j = 0; j < 4; ++j) { f32x4 a = ldg<f32x4>(pp + 256 * j);
#pragma unroll
        for (int ks = 1; ks < 8; ++ks) a += ldg<f32x4>(pp + (size_t)ks * (NBATCH * CTXL) * DM + 256 * j);
        v[j] = ldg<f32x4>(src + 256 * j) + (ldg<f32x4>(g0 + 256 * j) + ldg<f32x4>(gb0 + 256 * j)) * a;
        s += (v[j][0] * v[j][0] + v[j][1] * v[j][1]) + (v[j][2] * v[j][2] + v[j][3] * v[j][3]); }
    s = wave_sum(s, lane);
    LAS float* red = (LAS float*)lds;
    if (lane == 0) red[wave] = s;
    __syncthreads();
    const float rstd = rsqrtf(((red[wave & 4] + red[(wave & 4) + 1]) + (red[(wave & 4) + 2] + red[(wave & 4) + 3])) * (1.f / DM) + EPS);
    const float* mp = (const float*)(P.ws + WS_CTL + CTL_MOD_OFF) + (size_t)3 * MODW + (size_t)2 * MODW; const float* bm = P.b_mod + MODW; const float* gn = P.g_norm + DM;
    bf16* o = (bf16*)(P.ws + WS_XN) + (size_t)(b * TT + tau) * DM + 1024 * q + 4 * lane;
#pragma unroll
    for (int j = 0; j < 4; ++j) { const int k = 1024 * q + 4 * lane + 256 * j;
        const f32x4 g4 = ldg<f32x4>(gn + k), sh = ldg<f32x4>(mp + k) + ldg<f32x4>(bm + k), sc = ldg<f32x4>(mp + DM + k) + ldg<f32x4>(bm + DM + k);
        const f32x4 h = v[j] * rstd * g4 * (sc + 1.0f) + sh;
        u32x2 w; w.x = cvtpk(h[0], h[1]); w.y = cvtpk(h[2], h[3]); stg<u32x2>(o + 256 * j, w); }
    __syncthreads();
}

__device__ __forceinline__ void p2_gates(const Ptrs& P, int layer, LAS unsigned char* lds, int bid, int nblk, int wave, int lane, int tid) {
    const bf16* XN = (const bf16*)(P.ws + WS_XN); const bf16* WgT = (const bf16*)(P.ws + WS_WGT) + (size_t)layer * 16 * DM; float* G = (float*)(P.ws + WS_GATES);
    LAS float* red = (LAS float*)lds;
    const int i16 = lane & 15, g = lane >> 4;
    bf16x8 bfr[16];
#pragma unroll
    for (int s = 0; s < 16; ++s) bfr[s] = ldg<bf16x8>(WgT + (size_t)i16 * DM + wave * 512 + 32 * s + 8 * g);
    for (int p = bid; p < NPANEL; p += nblk) {
        f32x4 acc = {0.f, 0.f, 0.f, 0.f};
        const bf16* ap = XN + (size_t)(16 * p + i16) * DM + wave * 512 + 8 * g;
#pragma unroll
        for (int s = 0; s < 16; ++s) { const bf16x8 a = ldg<bf16x8>(ap + 32 * s); acc = mfma16(a, bfr[s], acc); }
#pragma unroll
        for (int r = 0; r < 4; ++r) red[wave * 256 + (4 * g + r) * 16 + i16] = acc[r];
        __syncthreads();
        if (tid < 256) { float s = 0.f;
#pragma unroll
            for (int w = 0; w < 8; ++w) s += red[w * 256 + tid];
            stg<float>(G + (size_t)(16 * p + (tid >> 4)) * 16 + (tid & 15), s + ldg<float>(P.b_gate + layer * 16 + (tid & 15))); }
        __syncthreads();
    }
}

__device__ __forceinline__ void p2b_qk_item(const Ptrs& P, int layer, int R, int pass, int lane) {
    const int tau = R % TT; const int li = lane & 15;
    const size_t eo = pass < 4 ? (size_t)R * AQW + pass * 512 + 8 * lane : (size_t)R * AKW + 8 * lane;
    const bf16* ptr = (const bf16*)(P.ws + (pass < 4 ? WS_AQ : WS_AK)) + eo; bf16* optr = (bf16*)(P.ws + (pass < 4 ? WS_AQN : WS_AKN)) + eo;
    const float* gg = (pass < 4 ? P.g_q : P.g_k) + (size_t)layer * HD;
    const u32x4 raw = ldg<u32x4>(ptr);
    float xv[8];
#pragma unroll
    for (int i = 0; i < 4; ++i) { xv[2 * i] = bflo(raw[i]); xv[2 * i + 1] = bfhi(raw[i]); }
    float ss = 0.f;
#pragma unroll
    for (int e = 0; e < 8; ++e) ss += xv[e] * xv[e];
    ss += shl_xor(ss, 1, lane); ss += shl_xor(ss, 2, lane); ss += shl_xor(ss, 4, lane); ss += shl_xor(ss, 8, lane);
    const float rstd = rsqrtf(ss * (1.f / HD) + EPS);
    const int base1 = li < 8 ? 4 * li : 4 * li + 32;
    const f32x4 g1 = ldg<f32x4>(gg + base1), g2 = ldg<f32x4>(gg + base1 + 32);
    float x1[4], x2[4];
#pragma unroll
    for (int q = 0; q < 4; ++q) { x1[q] = xv[2 * q] * rstd * g1[q]; x2[q] = xv[2 * q + 1] * rstd * g2[q]; }
    if (tau >= CTXL) {
        const int t = tau - CTXL; const int pos = li < 8 ? (t >> 6) : (t & 63);
        const float* tab = (const float*)(P.ws + WS_ROPE);
        const f32x4 cs = ldg<f32x4>(tab + pos * 32 + 4 * (li & 7)), sn = ldg<f32x4>(tab + 2048 + pos * 32 + 4 * (li & 7));
#pragma unroll
        for (int q = 0; q < 4; ++q) { const float a = x1[q], b = x2[q]; x1[q] = a * cs[q] - b * sn[q]; x2[q] = a * sn[q] + b * cs[q]; }
    }
    u32x4 o; o.x = cvtpk(x1[0], x2[0]); o.y = cvtpk(x1[1], x2[1]); o.z = cvtpk(x1[2], x2[2]); o.w = cvtpk(x1[3], x2[3]);
    stg<u32x4>(optr, o);
}
__device__ __forceinline__ void p2b_tr_item(const bf16* __restrict__ src, int ld, bf16* __restrict__ dstb, int NRT, int r0, int step0, LAS bf16* scr, int lane) {
    const int rr = lane >> 3, cg = lane & 7;
    u32x4 v[8];
#pragma unroll
    for (int i = 0; i < 8; ++i) v[i] = ldg<u32x4>(src + (size_t)(8 * i + rr) * ld + 8 * cg);
#pragma unroll
    for (int i = 0; i < 8; ++i) { const int row = 8 * i + rr;
#pragma unroll
        for (int e = 0; e < 4; ++e) { scr[(8 * cg + 2 * e) * 72 + row] = (bf16)(v[i][e] & 0xffffu); scr[(8 * cg + 2 * e + 1) * 72 + row] = (bf16)(v[i][e] >> 16); } }
    LDS_WAIT();
    { const int i16 = lane & 15, g = lane >> 4;
#pragma unroll
      for (int f = 0; f < 8; ++f) { const int rtl = f >> 1, stl = f & 1;
          const u32x4 o = *(const LAS u32x4*)(scr + (16 * rtl + i16) * 72 + 32 * stl + 8 * g);
          stg<u32x4>(dstb + ((size_t)(step0 + stl) * NRT + (r0 >> 4) + rtl) * 512 + lane * 8, o); } }
    LDS_WAIT();
}
__device__ __forceinline__ int chunk_at(int dir, int step) { return dir == 0 ? step : (step == 0 ? 1 : (step == 1 ? 0 : 35 - step)); }
__device__ __forceinline__ void p2b_scan_item(const Ptrs& P, int seq, int j, int lane) {
    const int dir = seq >> 3, b = (seq >> 2) & 1, h = seq & 3;
    const float* G = (const float*)(P.ws + WS_GATES);
    float* U = (float*)(P.ws + WS_SCAN) + (size_t)seq * TT; float* BCp = U + NSEQ * TT; float* CMp = BCp + NSEQ * TT;
    float* BT = (float*)(P.ws + WS_ACH) + seq * NCH; float* UM = BT + NSEQ * NCH;
    const int p0 = 2 * lane, p1 = 2 * lane + 1;
    const int t0 = dir == 0 ? p0 : 127 - p0, t1 = dir == 0 ? p1 : 127 - p1;
    const size_t R0 = (size_t)b * TT + CHK * j;
    const float i0 = ldg<float>(G + (R0 + t0) * 16 + dir * 8 + h), f0 = ldg<float>(G + (R0 + t0) * 16 + dir * 8 + 4 + h);
    const float i1 = ldg<float>(G + (R0 + t1) * 16 + dir * 8 + h), f1 = ldg<float>(G + (R0 + t1) * 16 + dir * 8 + 4 + h);
    const float lf0 = fminf(f0, 0.f) - log1pf(expf(-fabsf(f0))), lf1 = fminf(f1, 0.f) - log1pf(expf(-fabsf(f1)));
    float tot = lf0 + lf1, inc = tot;
#pragma unroll
    for (int o = 1; o < 64; o <<= 1) { const float y = shl_up(inc, o, lane); if (lane >= o) inc += y; }
    const float ex = inc - tot, b0 = ex + lf0, b1 = ex + tot;
    const float u0 = i0 - b0, u1 = i1 - b1;
    float cm = fmaxf(u0, u1), cinc = cm;
#pragma unroll
    for (int o = 1; o < 64; o <<= 1) { const float y = shl_up(cinc, o, lane); if (lane >= o) cinc = fmaxf(cinc, y); }
    float cex = shl_up(cinc, 1, lane); if (lane == 0) cex = -3.0e38f;
    const int o0 = CHK * j + t0, o1 = CHK * j + t1;
    stg<float>(U + o0, u0); stg<float>(U + o1, u1); stg<float>(BCp + o0, b0); stg<float>(BCp + o1, b1);
    stg<float>(CMp + o0, fmaxf(cex, u0)); stg<float>(CMp + o1, cinc);
    if (lane == 63) { stg<float>(BT + j, b1); stg<float>(UM + j, cinc); }
}

__device__ __forceinline__ bf16x8 scale_frag8(bf16x8 f, const f32x4 w0, const f32x4 w1) {
    u32x4 u = __builtin_bit_cast(u32x4, f);
    u.x = cvtpk(bflo(u.x) * w0[0], bfhi(u.x) * w0[1]); u.y = cvtpk(bflo(u.y) * w0[2], bfhi(u.y) * w0[3]);
    u.z = cvtpk(bflo(u.z) * w1[0], bfhi(u.z) * w1[1]); u.w = cvtpk(bflo(u.w) * w1[2], bfhi(u.w) * w1[3]);
    return __builtin_bit_cast(bf16x8, u);
}

__device__ __forceinline__ void p3_chain_block(const Ptrs& P, int cb, int wave, int lane, LAS unsigned char* lds) {
    const int seq = cb >> 1, vh = cb & 1, kt = wave & 3, vq = wave >> 2;
    const int dir = seq >> 3, b = (seq >> 2) & 1, h = seq & 3;
    const int i16 = lane & 15, g = lane >> 4;
    const unsigned lane16 = (unsigned)lane * 16u;
    const char* dsrc = wave < 4 ? (const char*)(P.ws + WS_KT) + ((size_t)(b * MH + h) * (4 * NCH * 16) + 4 * wave) * 1024
                                : (const char*)(P.ws + WS_VT) + ((size_t)(b * MH + h) * (4 * NCH * 32) + 16 * vh + 4 * (wave - 4)) * 1024;
    const unsigned dstep = wave < 4 ? 16u * 1024u : 32u * 1024u;
    LAS unsigned char* ring = lds;
    LAS float* wl = (LAS float*)(lds + 131072) + wave * 128;
    const char* UB = (const char*)((const float*)(P.ws + WS_SCAN) + (size_t)seq * TT);
    LAS unsigned char* ual = lds + 135168;
    float mc_l = 0.f, mu_l = 0.f;
    { float* BT = (float*)(P.ws + WS_ACH) + seq * NCH; float* UM = BT + NSEQ * NCH; float* MC = UM + NSEQ * NCH; float* MU = MC + NSEQ * NCH;
      const int jl = chunk_at(dir, lane < NCH ? lane : 0);
      const float btv = ldg<float>(BT + jl), umv = ldg<float>(UM + jl);
      float m = 0.f;
      for (int step = 0; step < NCH; ++step) { const float bt = shl_idx(btv, step), um = shl_idx(umv, step), mu = fmaxf(m, um); if (lane == step) { mc_l = m; mu_l = mu; } m = bt + mu; }
      if (vh == 0 && wave == 0 && lane < NCH) { stg<float>(MC + jl, mc_l); stg<float>(MU + jl, mu_l); } }
    float mu_cur = 0.f, ac = 1.f;
    char* CSTu = (char*)((bf16*)(P.ws + WS_CST) + ((size_t)seq * NCH) * MDV * MDK) + ((size_t)(16 * vh + 8 * vq) * 8 + 2 * kt) * 1024;
    char* NSTu = (char*)((float*)(P.ws + WS_NST) + (size_t)seq * NCH * MDK + 64 * kt);
    f32x4 C[4][8];
#pragma unroll
    for (int a = 0; a < 4; ++a)
#pragma unroll
        for (int bb = 0; bb < 8; ++bb) C[a][bb] = (f32x4){0.f, 0.f, 0.f, 0.f};
    f32x4 Nacc[4];
#pragma unroll
    for (int a = 0; a < 4; ++a) Nacc[a] = (f32x4){0.f, 0.f, 0.f, 0.f};
#define CHB_DMA(sub) do { const int st_ = 4 * chunk_at(dir, (sub) >> 2) + ((sub) & 3); const char* sp_ = dsrc + (size_t)st_ * dstep; asm volatile("" : "+s"(sp_)); \
        LAS unsigned char* dp_ = ring + (((sub) & 3) * 32 + 4 * wave) * 1024; \
        _Pragma("unroll") for (int q = 0; q < 4; ++q) __builtin_amdgcn_global_load_lds((const unsigned*)(sp_ + lane16 + q * 1024), (LAS unsigned*)(dp_ + q * 1024), 16, 0, 0); } while (0)
#define CHB_STEP(s, PP) do { \
        if ((PP) == 0) asm volatile("s_waitcnt vmcnt(8) lgkmcnt(0)" ::: "memory"); else asm volatile("s_waitcnt vmcnt(29) lgkmcnt(0)" ::: "memory"); \
        __builtin_amdgcn_s_barrier(); asm volatile("" ::: "memory"); \
        CHB_DMA((s) + 3); \
        asm volatile("" ::: "memory"); \
        if ((PP) == 0) { \
            int ln_ = lane; asm volatile("" : "+v"(ln_));            \
            const unsigned cstl_ = (unsigned)((ln_ & 15) + 16 * (2 * ((ln_ >> 4) & 1) + (ln_ >> 5))) * 16u, nstl_ = (unsigned)(ln_ >> 4) * 16u, l8_ = (unsigned)ln_ * 8u; \
            { const float mc = shl_idx(mc_l, (s) >> 2); mu_cur = shl_idx(mu_l, (s) >> 2); ac = __expf(mc - mu_cur); } \
            { const f32x2 un = *(const LAS f32x2*)(ual + (((s) >> 2) & 1) * 1024 + l8_); f32x2 w2; w2.x = __expf(un.x - mu_cur); w2.y = __expf(un.y - mu_cur); *(LAS f32x2*)(wl + 2 * ln_) = w2; } \
            asm volatile("s_waitcnt lgkmcnt(0)" ::: "memory"); \
            { const int cn_ = ((s) >> 2) + 1 < NCH ? ((s) >> 2) + 1 : NCH - 1; const char* up_ = UB + (size_t)(CHK * chunk_at(dir, cn_)) * 4; asm volatile("" : "+s"(up_)); \
              __builtin_amdgcn_global_load_lds((const unsigned*)(up_ + lane16), (LAS unsigned*)(ual + ((((s) >> 2) + 1) & 1) * 1024), 16, 0, 0); }     \
            const int jc_ = chunk_at(dir, (s) >> 2); \
            char* cst = CSTu + (size_t)jc_ * MDV * MDK * 2; char* nst = NSTu + (size_t)jc_ * MDK * 4; asm volatile("" : "+s"(cst), "+s"(nst)); \
              \
            _Pragma("unroll") for (int m = 0; m < 2; ++m) _Pragma("unroll") for (int bb = 0; bb < 8; ++bb) { \
                    const unsigned x0 = cvtpk(C[2 * m][bb][0], C[2 * m][bb][1]), x1 = cvtpk(C[2 * m][bb][2], C[2 * m][bb][3]), y0 = cvtpk(C[2 * m + 1][bb][0], C[2 * m + 1][bb][1]), y1 = cvtpk(C[2 * m + 1][bb][2], C[2 * m + 1][bb][3]); \
                    const auto s0_ = __builtin_amdgcn_permlane16_swap(x0, y0, false, false); const auto s1_ = __builtin_amdgcn_permlane16_swap(x1, y1, false, false); \
                    const u32x4 o = {s0_[0], s1_[0], s0_[1], s1_[1]}; \
                    stg<u32x4>(cst + cstl_ + (bb * 8 + m) * 1024, o); \
                    C[2 * m][bb] = C[2 * m][bb] * ac; C[2 * m + 1][bb] = C[2 * m + 1][bb] * ac; \
                    if (bb == 7) { asm volatile("" ::: "memory"); __builtin_amdgcn_sched_barrier(0); } } \
            _Pragma("unroll") for (int a = 0; a < 4; ++a) { stg<f32x4>(nst + nstl_ + 64 * a, Nacc[a]); Nacc[a] = Nacc[a] * ac; }     \
            asm volatile("" ::: "memory"); \
        } \
        { const LAS unsigned char* sl_ = ring + ((s) & 3) * 32768 + lane16; \
          const f32x4 W0 = *(const LAS f32x4*)(wl + 32 * (PP) + 8 * g), W1 = *(const LAS f32x4*)(wl + 32 * (PP) + 8 * g + 4); \
          bf16x8 kf[4]; \
          _Pragma("unroll") for (int a = 0; a < 4; ++a) kf[a] = scale_frag8(*(const LAS bf16x8*)(sl_ + (4 * kt + a) * 1024), W0, W1); \
          _Pragma("unroll") for (int bb = 0; bb < 8; ++bb) { const bf16x8 vf = *(const LAS bf16x8*)(sl_ + (16 + 8 * vq + bb) * 1024); \
              _Pragma("unroll") for (int a = 0; a < 4; ++a) C[a][bb] = mfma16(kf[a], vf, C[a][bb]);        \
              if ((bb & 3) == 3) { asm volatile("" ::: "memory"); __builtin_amdgcn_sched_barrier(0); } } \
          { unsigned o1_ = 0x3F803F80u; asm volatile("" : "+v"(o1_)); const u32x4 ou_ = {o1_, o1_, o1_, o1_}; const bf16x8 ones = __builtin_bit_cast(bf16x8, ou_);     \
            _Pragma("unroll") for (int a = 0; a < 4; ++a) Nacc[a] = mfma16(kf[a], ones, Nacc[a]); } } \
        asm volatile("" ::: "memory"); __builtin_amdgcn_sched_barrier(0); } while (0)
    __builtin_amdgcn_global_load_lds((const unsigned*)(UB + (size_t)(CHK * chunk_at(dir, 0)) * 4 + lane16), (LAS unsigned*)ual, 16, 0, 0);
    asm volatile("s_waitcnt vmcnt(0)" ::: "memory");
    CHB_DMA(0); CHB_DMA(1); CHB_DMA(2);
#pragma clang loop unroll(disable)
    for (int sub = 0; sub < 132; sub += 12) {
        asm volatile("" : "+s"(sub));
        CHB_STEP(sub + 0, 0);
        CHB_STEP(sub + 1, 1);
        CHB_STEP(sub + 2, 2);
        CHB_STEP(sub + 3, 3);
        CHB_STEP(sub + 4, 0);
        CHB_STEP(sub + 5, 1);
        CHB_STEP(sub + 6, 2);
        CHB_STEP(sub + 7, 3);
        CHB_STEP(sub + 8, 0);
        CHB_STEP(sub + 9, 1);
        CHB_STEP(sub + 10, 2);
        CHB_STEP(sub + 11, 3);
    }
    CHB_STEP(132 + 0, 0);
    CHB_STEP(132 + 1, 1);
    CHB_STEP(132 + 2, 2);
    CHB_STEP(132 + 3, 3);
#undef CHB_STEP
#undef CHB_DMA
    asm volatile("s_waitcnt vmcnt(0) lgkmcnt(0)" ::: "memory");
}

template <int KIND> __device__ __forceinline__ void p4_tile_load(u32x4 (&st)[4], const bf16* src, int ld, int tid) {
#pragma unroll
    for (int q = 0; q < 4; ++q) { const int c = tid + 512 * q;
        if (KIND == 0) { const int row = c >> 5, cc = c & 31; st[q] = ldg<u32x4>(src + (size_t)row * ld + 8 * cc); }
        else { const int f = c >> 6, l = c & 63; st[q] = ldg<u32x4>(src + (size_t)(f >> 3) * ld + ((f & 7) * 64 + l) * 8); } }
}
template <int KIND, bool KSWZ_> __device__ __forceinline__ void p4_tile_write(const u32x4 (&st)[4], LAS unsigned char* buf, int tid) {
#pragma unroll
    for (int q = 0; q < 4; ++q) { const int c = tid + 512 * q;
        if (KIND == 0) { const int row = c >> 5, cc = c & 31; const int f = KSWZ_ ? ((row & 3) | (((row >> 3) & 3) << 2)) : (row & 15);
            *(LAS u32x4*)(buf + row * 512 + ((cc ^ f) << 4)) = st[q]; }
        else if (KIND == 1) *(LAS u32x4*)(buf + c * 16) = st[q];
        else { const int f = c >> 6, l = c & 63, row = 16 * (f >> 3) + (l & 15), cc = 4 * (f & 7) + (l >> 4);
            *(LAS u32x4*)(buf + row * 512 + ((cc ^ (row & 15)) << 4)) = st[q]; } }
}
__device__ __forceinline__ void p4_m2_unit(const Ptrs& P, int layer, int b, int h, int j, int wave, int tid_in, LAS unsigned char* lds, const bool skip_epi = false) {
    int tid = tid_in; asm volatile("" : "+v"(tid));
    const int lane = tid & 63, i16 = lane & 15, g = lane >> 4;
    const int R0 = b * TT + CHK * j, t_loc = 16 * wave + i16;
    const bf16* mq = (const bf16*)(P.ws + WS_MQ); const bf16* mk = (const bf16*)(P.ws + WS_MK); const bf16* vT = (const bf16*)(P.ws + WS_VT);
    const bf16* CST = (const bf16*)(P.ws + WS_CST); const float* NST = (const float*)(P.ws + WS_NST);
    const float* U = (const float*)(P.ws + WS_SCAN); const float* BCp = U + NSEQ * TT; const float* CMp = BCp + NSEQ * TT; const float* MCp = (const float*)(P.ws + WS_ACH) + 2 * NSEQ * NCH;
    const int seqf = b * 4 + h, seqb = (2 + b) * 4 + h;
    const bf16* ksrc = mk + (size_t)R0 * MQW + h * MDK;
    const bf16* vsrc = vT + (size_t)(b * MH + h) * (4 * NCH * 32 * 512) + (size_t)(4 * j) * (32 * 512);
    constexpr int VSTEP = 32 * 512;
    const bf16* cfsrc = CST + ((size_t)seqf * NCH + j) * MDV * MDK; const bf16* cbsrc = CST + ((size_t)seqb * NCH + j) * MDV * MDK;
    const bf16* qp = mq + (size_t)(R0 + t_loc) * MQW + h * MDK + 8 * g;
    bf16x8 qf[8];
    const unsigned lane16 = (unsigned)lane * 16u;
    constexpr int M2R = MK_M2RING;
#define M2_DST(i, jj) (lds + ((i) % M2R) * 32768 + wave * 4096 + (jj) * 1024)
#define M2_DMA_K(i, kt) do { _Pragma("unroll") for (int jj = 0; jj < 4; ++jj) { const int row = wave * 8 + jj * 2 + (lane >> 5), slot = lane & 31, cc = slot ^ ((row & 3) | (((row >> 3) & 3) << 2)); \
        __builtin_amdgcn_global_load_lds((const unsigned*)(ksrc + (size_t)(64 * (kt) + row) * MQW + cc * 8), (LAS unsigned*)M2_DST(i, jj), 16, 0, 0); } } while (0)
#define M2_DMA_V(i, vt) do { _Pragma("unroll") for (int jj = 0; jj < 4; ++jj) { const int f = wave * 4 + jj; \
        __builtin_amdgcn_global_load_lds((const unsigned*)((const char*)(vsrc + (size_t)(8 * (vt)) * 512 + (size_t)(f >> 3) * VSTEP + (f & 7) * 512) + lane16), (LAS unsigned*)M2_DST(i, jj), 16, 0, 0); } } while (0)
#define M2_DMA_C(i, base, ct) do { _Pragma("unroll") for (int jj = 0; jj < 4; ++jj) \
        __builtin_amdgcn_global_load_lds((const unsigned*)((const char*)((base) + (size_t)(ct) * 16384 + (wave * 4 + jj) * 512) + lane16), (LAS unsigned*)M2_DST(i, jj), 16, 0, 0); } while (0)
#define M2_DMA(i) do { if ((i) < 2) M2_DMA_K(i, i); else if ((i) < 6) M2_DMA_V(i, (i) - 2); else if ((i) < 14) M2_DMA_C(i, cfsrc, (i) - 6); else if ((i) < 22) M2_DMA_C(i, cbsrc, (i) - 14); } while (0)
#define M2_SYNC(K) do { asm volatile("s_waitcnt vmcnt(" #K ") lgkmcnt(0)" ::: "memory"); __builtin_amdgcn_s_barrier(); asm volatile("" ::: "memory"); } while (0)
#pragma unroll
    for (int ks = 0; ks < 8; ++ks) qf[ks] = ldg<bf16x8>(qp + 32 * ks);
    asm volatile("" ::: "memory");
    M2_DMA(0); M2_DMA(1); if (M2R == 4) M2_DMA(2);
    f32x4 S[8];
#pragma unroll
    for (int T = 0; T < 8; ++T) S[T] = (f32x4){0.f, 0.f, 0.f, 0.f};
#pragma unroll
    for (int kt = 0; kt < 2; ++kt) {
        if (M2R == 4) M2_SYNC(8); else M2_SYNC(4);
        M2_DMA(kt + M2R - 1);
        asm volatile("" ::: "memory");
        const LAS unsigned char* bufr = lds + (kt % M2R) * 32768;
        bf16x8 kfr[2][4];
#define M2_KRD(ks, tl) (*(const LAS bf16x8*)(bufr + (32 * ((tl) >> 1) + 8 * (i16 >> 2) + 4 * ((tl) & 1) + (i16 & 3)) * 512 + (((4 * (ks) + g) ^ i16) << 4)))
#pragma unroll
        for (int tl = 0; tl < 4; ++tl) kfr[0][tl] = M2_KRD(0, tl);
#pragma unroll
        for (int ks = 0; ks < 8; ++ks) {
            if (ks < 7) {
#pragma unroll
                for (int tl = 0; tl < 4; ++tl) kfr[(ks + 1) & 1][tl] = M2_KRD(ks + 1, tl); }
            __builtin_amdgcn_sched_barrier(0);
#pragma unroll
            for (int tl = 0; tl < 4; ++tl) S[4 * kt + tl] = mfma16(kfr[ks & 1][tl], qf[ks], S[4 * kt + tl]);
            __builtin_amdgcn_sched_barrier(0);
        }
#undef M2_KRD
    }
    bf16x8 pf[2][4]; float cCr[2][4];
#pragma unroll
    for (int dir = 0; dir < 2; ++dir) {
        const int seq = (dir * 2 + b) * 4 + h;
        const size_t so = (size_t)seq * TT + CHK * j;
        const float mc = ldg<float>(MCp + seq * NCH + j), Mt = fmaxf(mc, ldg<float>(CMp + so + t_loc)), wst = __expf(mc - Mt), eneg = __expf(-(ldg<float>(BCp + so + t_loc) + Mt));
        f32x4 sdv[8]; float rs = 0.f;
#pragma unroll
        for (int T = 0; T < 8; ++T) { const f32x4 u4 = ldg<f32x4>(U + so + 32 * (T >> 1) + 8 * g + 4 * (T & 1));
#pragma unroll
            for (int r = 0; r < 4; ++r) { const int s = 32 * (T >> 1) + 8 * g + 4 * (T & 1) + r; const bool ok = dir == 0 ? (s <= t_loc) : (s >= t_loc);
                sdv[T][r] = ok ? S[T][r] * __expf(u4[r] - Mt) : 0.f; rs += sdv[T][r]; } }
        rs += shl_xor(rs, 16, lane); rs += shl_xor(rs, 32, lane);
        float qn = 0.f;
        { const float* np = NST + ((size_t)seq * NCH + j) * MDK + 8 * g;
#pragma unroll
          for (int ks = 0; ks < 8; ++ks) { const f32x4 n0 = ldg<f32x4>(np + 32 * ks), n1 = ldg<f32x4>(np + 32 * ks + 4); const u32x4 qu = __builtin_bit_cast(u32x4, qf[ks]);
              qn += bflo(qu.x) * n0[0] + bfhi(qu.x) * n0[1] + bflo(qu.y) * n0[2] + bfhi(qu.y) * n0[3] + bflo(qu.z) * n1[0] + bfhi(qu.z) * n1[1] + bflo(qu.w) * n1[2] + bfhi(qu.w) * n1[3]; } }
        qn += shl_xor(qn, 16, lane); qn += shl_xor(qn, 32, lane);
        const float den = wst * qn + rs, dn = fmaxf(fabsf(den), eneg), cS = 1.0f / dn, cC = wst * cS;
#pragma unroll
        for (int p = 0; p < 4; ++p) {
            u32x4 u; u.x = cvtpk(sdv[2 * p][0] * cS, sdv[2 * p][1] * cS); u.y = cvtpk(sdv[2 * p][2] * cS, sdv[2 * p][3] * cS);
            u.z = cvtpk(sdv[2 * p + 1][0] * cS, sdv[2 * p + 1][1] * cS); u.w = cvtpk(sdv[2 * p + 1][2] * cS, sdv[2 * p + 1][3] * cS); pf[dir][p] = __builtin_bit_cast(bf16x8, u);
        }
#pragma unroll
        for (int r = 0; r < 4; ++r) cCr[dir][r] = shl_idx(cC, 4 * g + r);
    }
    f32x4 H[32];
#pragma unroll
    for (int vt = 0; vt < 4; ++vt) {
        if (M2R == 4) M2_SYNC(8); else M2_SYNC(4);
        M2_DMA(vt + 2 + M2R - 1);
        asm volatile("" ::: "memory");
        const LAS unsigned char* bufr = lds + ((vt + 2) % M2R) * 32768;
#pragma unroll
        for (int n = 0; n < 8; ++n) H[8 * vt + n] = (f32x4){0.f, 0.f, 0.f, 0.f};
        bf16x8 vfr[2][4];
#define M2_VRD(bb, n) (*(const LAS bf16x8*)(bufr + ((8 * ((bb) >> 1) + 4 * ((bb) & 1) + (n)) * 64 + lane) * 16))
#pragma unroll
        for (int n = 0; n < 4; ++n) vfr[0][n] = M2_VRD(0, n);
#pragma unroll
        for (int bb = 0; bb < 8; ++bb) {
            if (bb < 7) {
#pragma unroll
                for (int n = 0; n < 4; ++n) vfr[(bb + 1) & 1][n] = M2_VRD(bb + 1, n); }
            __builtin_amdgcn_sched_barrier(0);
#pragma unroll
            for (int n = 0; n < 4; ++n) H[8 * vt + 4 * (bb & 1) + n] = mfma16(pf[0][bb >> 1], vfr[bb & 1][n], H[8 * vt + 4 * (bb & 1) + n]);
#pragma unroll
            for (int n = 0; n < 4; ++n) H[8 * vt + 4 * (bb & 1) + n] = mfma16(pf[1][bb >> 1], vfr[bb & 1][n], H[8 * vt + 4 * (bb & 1) + n]);
            __builtin_amdgcn_sched_barrier(0);
        }
#undef M2_VRD
    }
    bf16x8 qg[8];
    { unsigned zq2 = 0u; asm volatile("" : "+s"(zq2)); const int lq = (int)__builtin_amdgcn_mbcnt_hi(~0u, __builtin_amdgcn_mbcnt_lo(~0u, zq2));
      const bf16* qp2 = mq + (size_t)(R0 + 16 * wave + (lq & 15)) * MQW + h * MDK + 8 * (lq >> 4); asm volatile("" : "+v"(qp2) :: "memory");
#pragma unroll
      for (int ks = 0; ks < 8; ++ks) qg[ks] = ldg<bf16x8>(qp2 + 32 * ks); }
#pragma unroll
    for (int ct = 0; ct < 16; ++ct) {
        if (M2R == 4) { if (ct < 14) M2_SYNC(8); else if (ct == 14) M2_SYNC(4); else M2_SYNC(0); }
        else { if (ct < 15) M2_SYNC(4); else M2_SYNC(0); }
        M2_DMA(ct + 6 + M2R - 1);
        asm volatile("" ::: "memory");
        const LAS unsigned char* bufr = lds + ((ct + 6) % M2R) * 32768;
#define M2_CRD(ks, n) (*(const LAS bf16x8*)(bufr + ((8 * (n) + (ks)) * 64 + lane) * 16))
#pragma unroll
        for (int nh = 0; nh < 2; ++nh) {
            f32x4 tf[2]; bf16x8 cfr[2][2];
#pragma unroll
            for (int n = 0; n < 2; ++n) { tf[n] = (f32x4){0.f, 0.f, 0.f, 0.f}; cfr[0][n] = M2_CRD(0, 2 * nh + n); }
#pragma unroll
            for (int ks = 0; ks < 8; ++ks) {
                if (ks < 7) {
#pragma unroll
                    for (int n = 0; n < 2; ++n) cfr[(ks + 1) & 1][n] = M2_CRD(ks + 1, 2 * nh + n); }
                __builtin_amdgcn_sched_barrier(0);
#pragma unroll
                for (int n = 0; n < 2; ++n) tf[n] = mfma16(qg[ks], cfr[ks & 1][n], tf[n]);
                __builtin_amdgcn_sched_barrier(0);
            }
#pragma unroll
            for (int n = 0; n < 2; ++n) {
#pragma unroll
                for (int r = 0; r < 4; ++r) H[4 * (ct & 7) + 2 * nh + n][r] += cCr[ct >> 3][r] * tf[n][r];
                asm volatile("" : "+v"(H[4 * (ct & 7) + 2 * nh + n])); }
        }
#undef M2_CRD
    }
    asm volatile("s_waitcnt lgkmcnt(0)" ::: "memory"); __builtin_amdgcn_s_barrier(); asm volatile("" ::: "memory");
#undef M2_SYNC
#undef M2_DMA
#undef M2_DMA_C
#undef M2_DMA_V
#undef M2_DMA_K
#undef M2_DST
    unsigned zf = 0u; asm volatile("" : "+s"(zf)); int lnf = (int)__builtin_amdgcn_mbcnt_hi(~0u, __builtin_amdgcn_mbcnt_lo(~0u, zf)); asm volatile("" : "+v"(lnf));
    const int i16f = lnf & 15, gf = lnf >> 4;
    float ss[4] = {0.f, 0.f, 0.f, 0.f};
#pragma unroll
    for (int nt = 0; nt < 32; ++nt)
#pragma unroll
        for (int r = 0; r < 4; ++r) ss[r] += H[nt][r] * H[nt][r];
    float rstd[4];
#pragma unroll
    for (int r = 0; r < 4; ++r) { float s_ = ss[r]; s_ += shl_xor(s_, 1, lnf); s_ += shl_xor(s_, 2, lnf); s_ += shl_xor(s_, 4, lnf); s_ += shl_xor(s_, 8, lnf); rstd[r] = rsqrtf(s_ * (1.f / MDV) + EPS); }
    const int rowb = R0 + 16 * wave + 4 * gf, colb = h * MDV + i16f;
    const float* gm = P.g_mlstm + (size_t)layer * MVW + colb;
    const bf16* mg = (const bf16*)(P.ws + WS_MG) + (size_t)rowb * MVW + colb;
    bf16* Y = (bf16*)(P.ws + WS_Y) + (size_t)rowb * DM + colb;
    asm volatile("" : "+v"(gm), "+v"(mg), "+v"(Y));
#if MK_PER_PHASE
    if (skip_epi) return;
#endif
#if MK_EPILDS
    (void)mg; (void)Y;
    { LAS float* ep = (LAS float*)lds + wave * 2176;
      const int erow = lnf >> 5, epc = lnf & 31;
      const bf16* mge = (const bf16*)(P.ws + WS_MG) + (size_t)(R0 + 16 * wave + erow) * MVW + h * MDV + 4 * epc;
      bf16* Ye = (bf16*)(P.ws + WS_Y) + (size_t)(R0 + 16 * wave + erow) * DM + h * MDV + 4 * epc;
      asm volatile("" : "+v"(mge), "+v"(Ye) :: "memory");
#pragma unroll
      for (int ps = 0; ps < 4; ++ps) {
#pragma unroll
          for (int n8 = 0; n8 < 8; ++n8) { const float gmv = ldg<float>(gm + 16 * (8 * ps + n8));
#pragma unroll
              for (int r = 0; r < 4; ++r) ep[(4 * gf + r) * 132 + 16 * n8 + i16f] = H[8 * ps + n8][r] * rstd[r] * gmv; }
          asm volatile("s_waitcnt lgkmcnt(0)" ::: "memory"); __builtin_amdgcn_sched_barrier(0);
#pragma unroll
          for (int i = 0; i < 8; ++i) {
              const f32x4 v = *(const LAS f32x4*)(ep + (erow + 2 * i) * 132 + 4 * epc);
              const u32x2 gg = ldg<u32x2>(mge + (size_t)(2 * i) * MVW + 128 * ps);
              u32x2 w; w.x = cvtpk(v[0] * bflo(gg.x), v[1] * bfhi(gg.x)); w.y = cvtpk(v[2] * bflo(gg.y), v[3] * bfhi(gg.y));
              stg<u32x2>(Ye + (size_t)(2 * i) * DM + 128 * ps, w); }
          asm volatile("s_waitcnt lgkmcnt(0)" ::: "memory"); __builtin_amdgcn_sched_barrier(0);
      } }
#else
#pragma unroll
    for (int nt = 0; nt < 32; ++nt) { const float gmv = ldg<float>(gm + 16 * nt);
#pragma unroll
        for (int r = 0; r < 4; ++r) { const float gate = bf2f(ldg<bf16>(mg + (size_t)r * MVW + 16 * nt)); stg<bf16>(Y + (size_t)r * DM + 16 * nt, f2bf(H[nt][r] * rstd[r] * gmv * gate)); }
        if ((nt & 3) == 3) asm volatile("" ::: "memory"); }
#endif
}

constexpr int N_PHASES = 15;
struct Args { const float* in[14]; float* out; unsigned char* ws; int ph_lo, ph_hi; };
__global__ void __launch_bounds__(NWAVES * 64, 2) mk_fwd(Args args) {
    extern __shared__ __attribute__((aligned(16))) unsigned char lds_raw[];
    LAS unsigned char* lds = (LAS unsigned char*)lds_raw;
    volatile LAS unsigned* MISC = (volatile LAS unsigned*)(lds + MISC_OFF);
    const int tid0 = threadIdx.x;
    const int wave0 = __builtin_amdgcn_readfirstlane(tid0 >> 6);
    const int G = gridDim.x, NGW = G * NWAVES;
    unsigned* ctl = (unsigned*)(args.ws + WS_CTL);
    if (tid0 < 32) MISC[tid0] = 0u;
    __syncthreads();
    XcdBarrier bar; bar.bar = ctl + CW_BAR; bar.x = 0; bar.st = nullptr;
    if (!MK_PER_PHASE) bar = xcd_barrier_post(ctl + CW_BAR, MISC + 8);
    const int lo = args.ph_lo, hi = args.ph_hi & 0xff, psub = args.ph_hi >> 8;
    const bool defer_win1 = MK_DEFERWIN1 && !MK_PER_PHASE && gridDim.x == 256 && lo == 0 && hi == N_PHASES;
    const bool defer_wout = MK_DEFERWOUT && MK_CTXSKIP && !MK_PER_PHASE && gridDim.x == 256 && lo == 0 && hi == N_PHASES;
    const bool fusel0 = MK_FUSEL0 && MK_XR16 && !MK_PER_PHASE && gridDim.x == 256 && lo == 0 && hi == N_PHASES;
    const bool fusefin = MK_FUSEFIN && MK_XR16 && !MK_PER_PHASE && G == 256 && lo == 0 && hi == N_PHASES;
#define IN(k) (lo <= (k) && (k) < hi)
#define SEAM(k) do { if (IN(k) && IN((k) + 1)) { XcdBarrier b_ = bar; asm volatile("" : "+s"(b_.bar)); xcd_barrier(b_); } } while (0)
#define PHASE_IDS_G unsigned zg_ = 0u; asm volatile("" : "+s"(zg_)); int tidg = wave0 * 64 + (int)__builtin_amdgcn_mbcnt_hi(~0u, __builtin_amdgcn_mbcnt_lo(~0u, zg_)), bidg = blockIdx.x; asm volatile("" : "+v"(tidg)); asm volatile("" : "+s"(bidg)); \
    const __attribute__((address_space(4))) Args* kag_ = (const __attribute__((address_space(4))) Args*)__builtin_amdgcn_kernarg_segment_ptr(); asm volatile("" : "+s"(kag_)); \
    Ptrs Pg; Pg.x = kag_->in[0]; Pg.c = kag_->in[1]; Pg.ctx = kag_->in[2]; Pg.c_ctx = kag_->in[3]; Pg.w_mod = kag_->in[4]; Pg.b_mod = kag_->in[5]; Pg.g_norm = kag_->in[6]; Pg.w_in = kag_->in[7]; \
    Pg.b_gate = kag_->in[8]; Pg.g_mlstm = kag_->in[9]; Pg.g_q = kag_->in[10]; Pg.g_k = kag_->in[11]; Pg.w_out = kag_->in[12]; Pg.g_final = kag_->in[13]; Pg.out = kag_->out; Pg.ws = kag_->ws; \
    const int laneg = tidg & 63, waveg = __builtin_amdgcn_readfirstlane(tidg >> 6)
#define PHASE_IDS unsigned z_ = 0u; asm volatile("" : "+s"(z_)); int tid = wave0 * 64 + (int)__builtin_amdgcn_mbcnt_hi(~0u, __builtin_amdgcn_mbcnt_lo(~0u, z_)), bid = blockIdx.x; asm volatile("" : "+v"(tid)); asm volatile("" : "+s"(bid)); \
    const __attribute__((address_space(4))) Args* ka_ = (const __attribute__((address_space(4))) Args*)__builtin_amdgcn_kernarg_segment_ptr(); asm volatile("" : "+s"(ka_)); \
    Ptrs P; P.x = ka_->in[0]; P.c = ka_->in[1]; P.ctx = ka_->in[2]; P.c_ctx = ka_->in[3]; P.w_mod = ka_->in[4]; P.b_mod = ka_->in[5]; P.g_norm = ka_->in[6]; P.w_in = ka_->in[7]; \
    P.b_gate = ka_->in[8]; P.g_mlstm = ka_->in[9]; P.g_q = ka_->in[10]; P.g_k = ka_->in[11]; P.w_out = ka_->in[12]; P.g_final = ka_->in[13]; P.out = ka_->out; P.ws = ka_->ws; \
    const int lane = tid & 63, wave = __builtin_amdgcn_readfirstlane(tid >> 6), gw = bid * NWAVES + wave; (void)lane; (void)wave; (void)gw

    if (PH_ON(0) && IN(0)) { PHASE_IDS; p0_mod(P, gw, NGW, lane); }
    SEAM(0);
    if (PH_ON(0) && IN(1)) { PHASE_IDS; p0_prologue(P, lds, gw, NGW, wave, lane, defer_wout, defer_win1); __syncthreads(); }

#pragma clang loop unroll(disable)
    for (int layer = 0; layer < 2; ++layer) {
        const int pb = 2 + 6 * layer;
        if (PH_ON(1) && IN(pb)) { PHASE_IDS; if (fusel0 && layer == 1) p1_ctx_coop(P, lds, bid, wave, lane); else p1_norm(P, layer, gw, NGW, lane, G == 256, lds, tid); }
        SEAM(pb);
        if (PH_ON(2) && IN(pb + 1)) {
            PHASE_IDS;
            const bool gl_ = MK_GATESLIGHT && layer == 1 && MK_CTXSKIP && G == 256;
            if (!gl_) p2_gates(P, layer, lds, bid, G, wave, lane, tid);
            pg8::Gemm gm{(const bf16*)(P.ws + WS_XN), (const bf16*)(P.ws + WS_WINT) + (size_t)layer * NIN * DM, MROWS, NIN, DM, DM};
            RowOrder S; if (layer == 1 && MK_CTXSKIP) S.init(32, NIN / 256, G, bid, true, 32); else S.init(MROWS / 256, NIN / 256, G, bid, false);
            EpiIn E{(bf16*)(P.ws + WS_MQ), (bf16*)(P.ws + WS_MK), (bf16*)(P.ws + WS_MV), (bf16*)(P.ws + WS_MG), (bf16*)(P.ws + WS_AQ), (bf16*)(P.ws + WS_AK), (bf16*)(P.ws + WS_AV), (bf16*)(P.ws + WS_ASZ)};
            pg8::gemm_phase<EpiIn, RowOrder, PG8_ALIGN, PG8_SP2>(lds, gm, S, E, tid);
            if (gl_ && bid >= 160) { __syncthreads(); PHASE_IDS_G; p2_gates(Pg, layer, lds, bidg - 160, 96, waveg, laneg, tidg); }
            if (defer_wout && bid >= (layer == 0 ? 232 : 160)) { __syncthreads(); PHASE_IDS_G; const int fb_ = layer == 0 ? 232 : 160;
                p0_wout_items(Pg, lds, layer, (bidg - fb_) * NWAVES + waveg, (256 - fb_) * NWAVES, waveg, laneg); __syncthreads(); }
        }
        SEAM(pb + 1);
        if (PH_ON(3) && IN(pb + 2)) {
            PHASE_IDS;
            for (int it = (gw + NGW / 2) % NGW; it < NSEQ * NCH; it += NGW) p2b_scan_item(P, it / NCH, it % NCH, lane);
            for (int it = gw; it < MROWS * 5; it += NGW) { const int R = it / 5, pass = it % 5;
                if (layer == 1 && pass < 4 && (R % TT) < CTXL) continue;
                p2b_qk_item(P, layer, R, pass, lane); }
            LAS bf16* scr = (LAS bf16*)(lds + wave * 9216);
            for (int it = (gw + NGW / 4) % NGW; it < NBATCH * 68 * 48; it += NGW) { const int b = it / (68 * 48), r = it % (68 * 48), tb = r / 48, cbk = r % 48;
                if (cbk < 16) p2b_tr_item((const bf16*)(P.ws + WS_MK) + (size_t)(b * TT + 64 * tb) * MQW + 64 * cbk, MQW, (bf16*)(P.ws + WS_KT) + (size_t)(b * MH + (cbk >> 2)) * (4 * NCH * 16 * 512), 16, 64 * (cbk & 3), 2 * tb, scr, lane);
                else { const int cbv = cbk - 16; p2b_tr_item((const bf16*)(P.ws + WS_MV) + (size_t)(b * TT + 64 * tb) * MVW + 64 * cbv, MVW, (bf16*)(P.ws + WS_VT) + (size_t)(b * MH + (cbv >> 3)) * (4 * NCH * 32 * 512), 32, 64 * (cbv & 7), 2 * tb, scr, lane); } }
            __syncthreads();
        }
        SEAM(pb + 2);
        if (PH_ON(4) && IN(pb + 3)) {
            unsigned* qctr = ctl + CW_QUEUE + 64 * layer; unsigned* cdone = ctl + CW_QUEUE + 64 * (2 + layer);
            { PHASE_IDS;
              if (PH_ON(8) && bid < 32 && !(psub & 1)) { p3_chain_block(P, bid, wave, lane, lds);
                  __builtin_amdgcn_fence(__ATOMIC_RELEASE, "agent");
                  asm volatile("s_waitcnt vmcnt(0)" ::: "memory");
                  if (lane == 0) __hip_atomic_fetch_add(cdone, 1u, __ATOMIC_RELAXED, __HIP_MEMORY_SCOPE_AGENT); }
            }
            if (PH_ON(10)) {
            PHASE_IDS;
            constexpr int NFULL = 512 - NSPLIT, NPARTS = NPART * NSPLIT;
            const int nA = NFULL + NPARTS + (layer == 0 ? 32 : 0), jlo = layer == 0 ? 0 : 2, nj = NCH - jlo, nM = (psub & 2) ? 0 : NBATCH * MH * nj;
            unsigned* tickets = ctl + CW_QUEUE + 64 * 24 + 64 * layer;
            bool m2_ready = false;
            bool conv_todo = defer_win1 && layer == 0; int npop = 0; const int cslot = bid < 32 ? 0 : (bid & 3);
#define WIN1_SHARE() do { __syncthreads(); { PHASE_IDS_G; p0_win1_items(Pg, lds, bidg * NWAVES + waveg, 256 * NWAVES, waveg, laneg); } __syncthreads(); conv_todo = false; } while (0)
            for (;;) {
                if (conv_todo && npop == cslot) WIN1_SHARE();
                ++npop;
                unsigned zq_ = 0u; asm volatile("" : "+s"(zq_));
                const int tq = wave * 64 + (int)__builtin_amdgcn_mbcnt_hi(~0u, __builtin_amdgcn_mbcnt_lo(~0u, zq_));
                __syncthreads();
                if (tq == 0) MISC[0] = __hip_atomic_fetch_add(qctr, 1u, __ATOMIC_RELAXED, __HIP_MEMORY_SCOPE_AGENT);
                __syncthreads();
                const int qi = __builtin_amdgcn_readfirstlane((int)MISC[0]);
                if (qi >= nA + nM) break;
                int idx = qi;
                if (MK_QORDER == 1 && qi >= NFULL) { const int nC = nA - NFULL - NPARTS;
                    idx = qi < NFULL + nM ? nA + (qi - NFULL) : qi < NFULL + nM + NPARTS ? NFULL + (qi - NFULL - nM) : NFULL + NPARTS + (qi - NFULL - nM - NPARTS); (void)nC; }
#if MK_PER_PHASE
                if ((psub & 8) && idx >= 480 && idx < 512) continue;
                if ((psub & 16) && idx < 480) continue;
#endif
                if (idx < nA) {
                    int b, head, qrow0, seq, k0 = 0, pidx = 0; float* part = nullptr; unsigned* tick = nullptr;
                    int lu = idx;
                    if (idx >= NFULL && idx < NFULL + NPARTS) { const int hh = idx - NFULL, orph = hh / NPART; pidx = hh % NPART; lu = NFULL + orph;
                        part = (float*)(P.ws + WS_APART) + (size_t)orph * (NPART * 66 * 512); tick = tickets + orph; }
                    if (idx < NFULL + NPARTS) { b = lu >> 8; const int rem = lu & 255, kvh_ = rem >> 6, r2 = rem & 63, qb = r2 >> 2, gq = r2 & 3; head = kvh_ * 4 + gq; qrow0 = b * TT + CTXL + 256 * qb;
                        if (part) { k0 = 64 * (pidx < 2 ? 18 * pidx : 4 + 16 * pidx); seq = 64 * (pidx < 2 ? 18 : 16); } else seq = TT; }
                    else { const int r = idx - (NFULL + NPARTS); b = r >> 4; head = r & 15; qrow0 = b * TT; seq = CTXL; }
                    const int kvh = head >> 2;
                    unsigned za_ = 0u; asm volatile("" : "+s"(za_));
                    int tid_a = wave * 64 + (int)__builtin_amdgcn_mbcnt_hi(~0u, __builtin_amdgcn_mbcnt_lo(~0u, za_)); asm volatile("" : "+v"(tid_a));
                    const int ln_ = tid_a & 63;
                    float gqm = fmaxf(fabsf(ldg<float>(P.g_q + (size_t)layer * HD + ln_)), fabsf(ldg<float>(P.g_q + (size_t)layer * HD + 64 + ln_)));
                    float gkm = fmaxf(fabsf(ldg<float>(P.g_k + (size_t)layer * HD + ln_)), fabsf(ldg<float>(P.g_k + (size_t)layer * HD + 64 + ln_)));
#pragma unroll
                    for (int o_ = 1; o_ < 64; o_ <<= 1) { gqm = fmaxf(gqm, shl_xor(gqm, o_, ln_)); gkm = fmaxf(gkm, shl_xor(gkm, o_, ln_)); }
                    const float mfix = __int_as_float(__builtin_amdgcn_readfirstlane(__float_as_int(128.f * 1.02f * gqm * gkm)));
                    const bool usefix = MK_FIXM && (2.f * mfix * 0.088388347648318440f < 60.f);
                    if (usefix)
                    att::attn_dense_body<true>((const bf16*)(P.ws + WS_AQN) + (size_t)qrow0 * AQW + head * HD, (const bf16*)(P.ws + WS_AKN) + (size_t)(b * TT + k0) * AKW + kvh * HD,
                                         (const bf16*)(P.ws + WS_AV) + (size_t)(b * TT + k0) * AKW + kvh * HD, (const bf16*)(P.ws + WS_ASZ) + (size_t)qrow0 * AQW + head * HD,
                                         (bf16*)(P.ws + WS_Y) + (size_t)qrow0 * DM + MVW + head * HD, seq, (char*)lds_raw, tid_a, part, tick, pidx, MISC + 1, mfix, (psub & 32) != 0);
                    else
                    att::attn_dense_body<false>((const bf16*)(P.ws + WS_AQN) + (size_t)qrow0 * AQW + head * HD, (const bf16*)(P.ws + WS_AKN) + (size_t)(b * TT + k0) * AKW + kvh * HD,
                                         (const bf16*)(P.ws + WS_AV) + (size_t)(b * TT + k0) * AKW + kvh * HD, (const bf16*)(P.ws + WS_ASZ) + (size_t)qrow0 * AQW + head * HD,
                                         (bf16*)(P.ws + WS_Y) + (size_t)qrow0 * DM + MVW + head * HD, seq, (char*)lds_raw, tid_a, part, tick, pidx, MISC + 1, 0.f, (psub & 32) != 0);
                } else {
                    if (!m2_ready) {
                        if (wave == 0) { unsigned sp = 0u;
                            while (__hip_atomic_load(cdone, __ATOMIC_RELAXED, __HIP_MEMORY_SCOPE_AGENT) < 256u) { __builtin_amdgcn_s_sleep(4); if (++sp > (1u << 22)) break; }
                            __builtin_amdgcn_fence(__ATOMIC_ACQUIRE, "agent"); }
                        asm volatile("s_waitcnt vmcnt(0)" ::: "memory");
                        __syncthreads();
                        m2_ready = true;
                    }
                    const int u = idx - nA, j = jlo + u % nj, bh = u / nj;
                    unsigned zm_ = 0u; asm volatile("" : "+s"(zm_));
                    const int tm = wave * 64 + (int)__builtin_amdgcn_mbcnt_hi(~0u, __builtin_amdgcn_mbcnt_lo(~0u, zm_));
                    p4_m2_unit(P, layer, bh >> 2, bh & 3, j, wave, tm, lds, (psub & 32) != 0);
                }
            }
            if (conv_todo) WIN1_SHARE();
#undef WIN1_SHARE
            }
        }
        if (IN(pb + 3) && IN(pb + 5)) { XcdBarrier b_ = bar; asm volatile("" : "+s"(b_.bar)); xcd_barrier(b_); }
        if (PH_ON(6) && IN(pb + 5)) {
            PHASE_IDS;
            const bool ksplit = (layer == 0 && G == 256);
            pg8::Gemm gm{(const bf16*)(P.ws + WS_Y), (const bf16*)(P.ws + WS_WOUTT) + (size_t)layer * DM * DM, MROWS, DM, DM, DM};
            if (fusel0 && layer == 0) {
                EpiOutNormL0 EL{P.x, (const float*)(P.ws + WS_CTL + CTL_MOD_OFF), P.b_mod, (bf16*)(P.ws + WS_XR1), (bf16*)(P.ws + WS_XN),
                                (const float*)(P.ws + WS_CTL + CTL_MOD_OFF) + (size_t)3 * MODW, P.b_mod + MODW, P.g_norm + DM, (float*)(P.ws + WS_FSLOT), ctl + CW_FCNT + 64};
                PanelOrder SA{bid, 0}; pg8::gemm_phase<EpiOutNormL0, PanelOrder, false, PG8_SP2>(lds, gm, SA, EL, tid);
                __syncthreads();
                PanelOrder SB{bid, 1}; pg8::gemm_phase<EpiOutNormL0, PanelOrder, false, PG8_SP2>(lds, gm, SB, EL, tid);
                __syncthreads();
            } else if (fusefin && layer == 1) {
                EpiOutNorm EN{(const bf16*)(P.ws + WS_XR1), P.out, (const float*)(P.ws + WS_CTL + CTL_MOD_OFF) + (size_t)layer * 3 * MODW, P.b_mod + (size_t)layer * MODW, P.g_final,
                              (float*)(P.ws + WS_FSLOT), ctl + CW_FCNT};
                PanelOrder SA{bid, 0}; pg8::gemm_phase<EpiOutNorm, PanelOrder, false, PG8_SP2>(lds, gm, SA, EN, tid);
                __syncthreads();
                PanelOrder SB{bid, 1}; pg8::gemm_phase<EpiOutNorm, PanelOrder, false, PG8_SP2>(lds, gm, SB, EN, tid);
            } else {
            RowOrder S; S.init((layer == 1 || ksplit) ? 32 : 34, DM / 256, G, bid, layer == 1 || ksplit);
            EpiOut E{layer, P.x, P.ctx, (const float*)(P.ws + WS_XR1), (float*)(P.ws + WS_XR1), P.out, (const float*)(P.ws + WS_CTL + CTL_MOD_OFF) + (size_t)layer * 3 * MODW, P.b_mod + (size_t)layer * MODW};
            pg8::gemm_phase<EpiOut, RowOrder, PG8_ALIGN, PG8_SP2>(lds, gm, S, E, tid);
            }
            if (ksplit) {
                const int ks = bid & 7;
                pg8::Gemm g2{(const bf16*)(P.ws + WS_Y) + ks * 512, (const bf16*)(P.ws + WS_WOUTT) + ks * 512, MROWS, DM, 512, DM};
                KSplitOrder S2{bid};
                EpiPart E2{(float*)(P.ws + WS_PART), ks};
                pg8::gemm_phase<EpiPart, KSplitOrder, false, PG8_SP2>(lds, g2, S2, E2, tid);
            }
        }
        if (!(fusefin && layer == 1)) SEAM(pb + 5);
    }
    if (PH_ON(7) && IN(14) && !fusefin) {
        PHASE_IDS;
        for (int R = gw; R < NBATCH * SEQ; R += NGW) {
            float* row = P.out + (size_t)R * DM + 4 * lane;
            f32x4 v[16]; float s = 0.f;
#pragma unroll
            for (int j = 0; j < 16; ++j) { v[j] = ldg<f32x4>(row + 256 * j); s += (v[j][0] * v[j][0] + v[j][1] * v[j][1]) + (v[j][2] * v[j][2] + v[j][3] * v[j][3]); }
            const float rstd = rsqrtf(wave_sum(s, lane) * (1.f / DM) + EPS);
#pragma unroll
            for (int j = 0; j < 16; ++j) { const f32x4 g4 = ldg<f32x4>(P.g_final + 4 * lane + 256 * j); stg<f32x4>(row + 256 * j, v[j] * rstd * g4); }
        }
    }
#undef IN
#undef SEAM
}

__global__ void probe_set(unsigned* q, unsigned v0, unsigned v1, unsigned v2) { if (threadIdx.x == 0) { q[0] = v0; q[64] = v1; if (v2) { q[128] = v2; q[192] = v2; } } }
extern "C" void kernel_launch(void* const* d_in, const int* in_sizes, int n_in, void* d_out, int out_size, void* d_ws, size_t ws_size, hipStream_t stream) {
    static int grid = 0;
    if (grid == 0) {
        if (n_in != 14 || out_size != NBATCH * SEQ * DM || ws_size < WS_END) { fprintf(stderr, "kernel_launch: shape mismatch (n_in %d out %d ws %zu need %zu)\n", n_in, out_size, ws_size, (size_t)WS_END); grid = -1; return; }
        int dev = 0, cus = 0, per_cu = 0;
        if (hipGetDevice(&dev) != hipSuccess || hipDeviceGetAttribute(&cus, hipDeviceAttributeMultiprocessorCount, dev) != hipSuccess) { grid = -1; return; }
        if (hipFuncSetAttribute((const void*)mk_fwd, hipFuncAttributeMaxDynamicSharedMemorySize, LDS_BYTES) != hipSuccess) { fprintf(stderr, "kernel_launch: hipFuncSetAttribute failed\n"); grid = -1; return; }
        if (hipOccupancyMaxActiveBlocksPerMultiprocessor(&per_cu, (const void*)mk_fwd, NWAVES * 64, LDS_BYTES) != hipSuccess || per_cu < 1)
            fprintf(stderr, "kernel_launch: occupancy query reports %d blocks per CU\n", per_cu);
        (void)hipGetLastError();
        grid = cus > 0 ? cus : 256;
    }
    if (grid < 0) return;
    if (hipMemsetAsync((char*)d_ws + WS_CTL, 0, CTL_BYTES, stream) != hipSuccess) { fprintf(stderr, "kernel_launch: memset failed\n"); return; }
    Args a{};
    for (int i = 0; i < 14; ++i) a.in[i] = (const float*)d_in[i];
    a.out = (float*)d_out; a.ws = (unsigned char*)d_ws;
#if MK_PER_PHASE
    for (int ph = 0; ph < N_PHASES; ++ph) {
        const int kind = ph == 1 ? 0 : ph == 0 ? 11 : ph == 14 ? 7 : 1 + (ph - 2) % 6;
        const int nrep = 1 + MK_NREP * REP_ON(kind);
        for (int rep = 0; rep < nrep; ++rep) {
            if (MK_REP && kind == 4) { hipMemsetAsync((char*)d_ws + WS_CTL + CW_QUEUE * 4, (rep && MK_SUB == 1) ? 0x7f : 0, 1024, stream); hipMemsetAsync((char*)d_ws + WS_CTL + (CW_QUEUE + 64 * 24) * 4, 0, 512, stream);
                if (rep && MK_SUB == 2) hipLaunchKernelGGL(probe_set, dim3(1), dim3(64), 0, stream, (unsigned*)((char*)d_ws + WS_CTL) + CW_QUEUE, 544u, 512u, 0u);
                if (rep && MK_SUB == 9) hipLaunchKernelGGL(probe_set, dim3(1), dim3(64), 0, stream, (unsigned*)((char*)d_ws + WS_CTL) + CW_QUEUE, 544u, 512u, 256u); }
            a.ph_lo = ph; a.ph_hi = (ph + 1) | ((rep && MK_SUB == 3) ? (3 << 8) : (rep && MK_SUB == 4) ? (2 << 8) : (rep && MK_SUB == 6) ? (8 << 8) : (rep && MK_SUB == 7) ? (16 << 8) : (rep && MK_SUB == 8) ? (10 << 8) : (rep && MK_SUB == 9) ? (1 << 8) : (rep && MK_SUB == 10) ? (32 << 8) : 0); hipLaunchKernelGGL(mk_fwd, dim3(grid), dim3(NWAVES * 64), LDS_BYTES, stream, a); } }
#else
    a.ph_lo = 0; a.ph_hi = N_PHASES;
    hipLaunchKernelGGL(mk_fwd, dim3(grid), dim3(NWAVES * 64), LDS_BYTES, stream, a);
#endif
    const hipError_t le = hipPeekAtLastError();
    if (le != hipSuccess) fprintf(stderr, "kernel_launch: launch failed: %s\n", hipGetErrorName(le));
}
```
